# Optimizing an MI355X kernel written in HIP

```python
import jax, jax.numpy as jnp
from jax import lax
import numpy as np

D_MODEL = 1024
BATCH = 8
SEQ = 4096
DEPTH = 1

HEAD_DIM = 64
N_FOX_HEADS = 8
N_MOBA_HEADS = 8
FOX_WIDTH = N_FOX_HEADS * HEAD_DIM
MOBA_WIDTH = N_MOBA_HEADS * HEAD_DIM
Q_BLOCK = 128
MOBA_BLOCK = 256
MOBA_TOPK = 3
MOBA_Q_CHUNK = 32
ROPE_THETA = 10000.0
PLE_DIM = 256
N_GROUPS = 4
EXPERTS_PER_GROUP = 8
N_EXPERTS = N_GROUPS * EXPERTS_PER_GROUP
TOP_K_FINE = 2
D_EXPERT = 512
MOE_ROW_BLOCK = 128
RMS_EPS = 1e-6
IN_COLS = 3 * FOX_WIDTH + 3 * MOBA_WIDTH + N_FOX_HEADS + 2 * D_MODEL

kernel_name = 'fox_moba_hmoe_hybrid_block'


def rmsnorm(x, g):
    xf = x.astype(jnp.float32)
    y = xf * lax.rsqrt(jnp.mean(xf * xf, axis=-1, keepdims=True) + RMS_EPS)
    return (y * g.astype(jnp.float32)).astype(x.dtype)


def rope(x):
    s, d = x.shape[2], x.shape[3]
    half = d // 2
    inv = 1.0 / (ROPE_THETA ** (jnp.arange(0, d, 2, dtype=jnp.float32) / d))
    ang = jnp.arange(s, dtype=jnp.float32)[:, None] * inv[None, :]
    cos, sin = jnp.cos(ang), jnp.sin(ang)
    xf = x.astype(jnp.float32)
    x1, x2 = xf[..., :half], xf[..., half:]
    out = jnp.concatenate([x1 * cos - x2 * sin, x2 * cos + x1 * sin], axis=-1)
    return out.astype(x.dtype)


def forgetting_attention(q, k, v, log_f):
    b, h, s, d = q.shape
    c = jnp.cumsum(log_f, axis=-1)
    nqb = s // Q_BLOCK
    q_blocks = jnp.moveaxis(q.reshape(b, h, nqb, Q_BLOCK, d), 2, 0)
    c_blocks = jnp.moveaxis(c.reshape(b, h, nqb, Q_BLOCK), 2, 0)
    starts = jnp.arange(nqb, dtype=jnp.int32) * Q_BLOCK
    k_pos = jnp.arange(s, dtype=jnp.int32)
    scale = HEAD_DIM ** -0.5

    def block(args):
        qb, cb, s0 = args
        logits = jnp.einsum('bhqd,bhkd->bhqk', qb, k, preferred_element_type=jnp.float32) * scale
        logits = logits + cb[..., None] - c[:, :, None, :]
        q_pos = s0 + jnp.arange(Q_BLOCK, dtype=jnp.int32)
        causal = k_pos[None, :] <= q_pos[:, None]
        logits = jnp.where(causal, logits, -jnp.inf)
        probs = jax.nn.softmax(logits, axis=-1)
        return jnp.einsum('bhqk,bhkd->bhqd', probs.astype(v.dtype), v)

    out = lax.map(block, (q_blocks, c_blocks, starts))
    return jnp.moveaxis(out, 0, 2).reshape(b, h, s, d)


def moba_attention(q, k, v):
    b, h, s, d = q.shape
    nb = -(-s // MOBA_BLOCK)
    sp = nb * MOBA_BLOCK
    pad = sp - s
    q, k, v = [jnp.pad(t, ((0, 0), (0, 0), (0, pad), (0, 0))) for t in (q, k, v)]
    k_blocks = k.reshape(b, h, nb, MOBA_BLOCK, d)
    v_blocks = v.reshape(b, h, nb, MOBA_BLOCK, d)
    k_mean = jnp.mean(k_blocks.astype(jnp.float32), axis=3)
    gate = jnp.einsum('bhsd,bhnd->bhsn', q.astype(jnp.float32), k_mean)
    q_blk = jnp.arange(sp, dtype=jnp.int32) // MOBA_BLOCK
    past = jnp.arange(nb, dtype=jnp.int32)[None, :] < q_blk[:, None]
    gate = jnp.where(past, gate, -jnp.inf)
    n_sel = min(MOBA_TOPK, nb)
    _, sel = lax.top_k(gate, n_sel)
    sel_valid = sel < q_blk[:, None]

    nc = sp // MOBA_Q_CHUNK
    q_c = jnp.moveaxis(q.reshape(b, h, nc, MOBA_Q_CHUNK, d), 2, 0)
    sel_c = jnp.moveaxis(sel.reshape(b, h, nc, MOBA_Q_CHUNK, n_sel), 2, 0)
    val_c = jnp.moveaxis(sel_valid.reshape(b, h, nc, MOBA_Q_CHUNK, n_sel), 2, 0)
    starts = jnp.arange(nc, dtype=jnp.int32) * MOBA_Q_CHUNK
    gather = jax.vmap(jax.vmap(lambda blocks, ix: blocks[ix]))
    own_off = jnp.arange(MOBA_BLOCK, dtype=jnp.int32)
    scale = HEAD_DIM ** -0.5
    n_keys_sel = n_sel * MOBA_BLOCK

    def chunk(args):
        qc, sc, vc, s0 = args
        b0 = s0 // MOBA_BLOCK
        ks = gather(k_blocks, sc)
        vs = gather(v_blocks, sc)
        l_sel = jnp.einsum('bhqd,bhqnkd->bhqnk', qc, ks, preferred_element_type=jnp.float32) * scale
        l_sel = jnp.where(vc[..., None], l_sel, -jnp.inf).reshape(b, h, MOBA_Q_CHUNK, n_keys_sel)
        k_own = lax.dynamic_index_in_dim(k_blocks, b0, axis=2, keepdims=False)
        v_own = lax.dynamic_index_in_dim(v_blocks, b0, axis=2, keepdims=False)
        l_own = jnp.einsum('bhqd,bhkd->bhqk', qc, k_own, preferred_element_type=jnp.float32) * scale
        q_pos = s0 + jnp.arange(MOBA_Q_CHUNK, dtype=jnp.int32)
        k_pos = b0 * MOBA_BLOCK + own_off
        l_own = jnp.where(k_pos[None, :] <= q_pos[:, None], l_own, -jnp.inf)
        probs = jax.nn.softmax(jnp.concatenate([l_sel, l_own], axis=-1), axis=-1)
        p_sel = probs[..., :n_keys_sel].reshape(b, h, MOBA_Q_CHUNK, n_sel, MOBA_BLOCK)
        p_own = probs[..., n_keys_sel:]
        return (jnp.einsum('bhqnk,bhqnkd->bhqd', p_sel.astype(v.dtype), vs)
                + jnp.einsum('bhqk,bhkd->bhqd', p_own.astype(v.dtype), v_own))

    out = lax.map(chunk, (q_c, sel_c, val_c, starts))
    return jnp.moveaxis(out, 0, 2).reshape(b, h, sp, d)[:, :, :s]


def hierarchical_moe(h, w_group, b_group, w_fine, b_fine, w_gate, w_up, w_down):
    b, s, dm = h.shape
    t = b * s
    xt = h.reshape(t, dm)
    xf = xt.astype(jnp.float32)
    g_prob = jax.nn.softmax(xf @ w_group.astype(jnp.float32) + b_group.astype(jnp.float32), axis=-1)
    g_top, g_idx = lax.top_k(g_prob, 1)
    f_logits = (xf @ w_fine.astype(jnp.float32) + b_fine.astype(jnp.float32)).reshape(t, N_GROUPS, EXPERTS_PER_GROUP)
    f_logits = jnp.take_along_axis(f_logits, g_idx[:, :, None], axis=1)[:, 0]
    f_top, f_idx = lax.top_k(f_logits, TOP_K_FINE)
    weights = (g_top * jax.nn.softmax(f_top, axis=-1)).astype(h.dtype)
    expert_idx = g_idx * EXPERTS_PER_GROUP + f_idx

    n_assign = t * TOP_K_FINE
    flat_e = expert_idx.reshape(-1).astype(jnp.int32)
    flat_w = weights.reshape(-1)
    flat_t = jnp.repeat(jnp.arange(t, dtype=jnp.int32), TOP_K_FINE)
    order = jnp.argsort(flat_e)
    se, st, sw = flat_e[order], flat_t[order], flat_w[order]
    counts = jnp.bincount(flat_e, length=N_EXPERTS)
    starts = jnp.cumsum(counts) - counts
    padded = ((counts + MOE_ROW_BLOCK - 1) // MOE_ROW_BLOCK) * MOE_ROW_BLOCK
    pends = jnp.cumsum(padded)
    pstarts = pends - padded
    dest = pstarts[se] + (jnp.arange(n_assign, dtype=jnp.int32) - starts[se])
    n_rows = n_assign + N_EXPERTS * MOE_ROW_BLOCK
    n_blk = n_rows // MOE_ROW_BLOCK
    row_token = jnp.full((n_rows,), t, dtype=jnp.int32).at[dest].set(st)
    row_weight = jnp.zeros((n_rows,), dtype=h.dtype).at[dest].set(sw)
    block_start = jnp.arange(n_blk, dtype=jnp.int32) * MOE_ROW_BLOCK
    block_expert = jnp.minimum(jnp.searchsorted(pends, block_start, side='right'), N_EXPERTS - 1)
    x_pad = jnp.concatenate([xt, jnp.zeros((1, dm), xt.dtype)], axis=0)
    rows = x_pad[row_token].reshape(n_blk, MOE_ROW_BLOCK, dm)

    def expert_block(args):
        r, e = args
        return (jax.nn.silu(r @ w_gate[e]) * (r @ w_up[e])) @ w_down[e]

    out_rows = lax.map(expert_block, (rows, block_expert)).reshape(n_rows, dm)
    out = jax.ops.segment_sum(out_rows * row_weight[:, None], row_token, num_segments=t + 1)[:t]
    return out.reshape(b, s, dm)


def setup_inputs(seed: int = 0) -> dict:
    key = jax.random.key(seed)
    ks = jax.random.split(key, 24)
    f32 = jnp.float32

    def nrm(k, shape, fan_in):
        return jax.random.normal(k, shape, f32) * (fan_in ** -0.5)

    def gain(k, shape):
        return 1.0 + 0.01 * jax.random.normal(k, shape, f32)

    return {
        'x': jax.random.normal(ks[0], (BATCH, SEQ, D_MODEL), f32),
        'p': jax.random.normal(ks[1], (DEPTH, BATCH, SEQ, PLE_DIM), f32),
        'attn_norm': gain(ks[2], (DEPTH, D_MODEL)),
        'w_in': nrm(ks[3], (DEPTH, D_MODEL, IN_COLS), D_MODEL),
        'b_forget': 0.1 * jax.random.normal(ks[4], (DEPTH, N_FOX_HEADS), f32),
        'w_fox_branch': nrm(ks[5], (DEPTH, FOX_WIDTH, D_MODEL), FOX_WIDTH),
        'w_moba_branch': nrm(ks[6], (DEPTH, MOBA_WIDTH, D_MODEL), MOBA_WIDTH),
        'w_out': nrm(ks[7], (DEPTH, D_MODEL, D_MODEL), D_MODEL),
        'moe_norm': gain(ks[8], (DEPTH, D_MODEL)),
        'w_group': nrm(ks[9], (DEPTH, D_MODEL, N_GROUPS), D_MODEL),
        'b_group': 0.01 * jax.random.normal(ks[10], (DEPTH, N_GROUPS), f32),
        'w_fine': nrm(ks[11], (DEPTH, D_MODEL, N_EXPERTS), D_MODEL),
        'b_fine': 0.01 * jax.random.normal(ks[12], (DEPTH, N_EXPERTS), f32),
        'w_gate': nrm(ks[13], (DEPTH, N_EXPERTS, D_MODEL, D_EXPERT), D_MODEL),
        'w_up': nrm(ks[14], (DEPTH, N_EXPERTS, D_MODEL, D_EXPERT), D_MODEL),
        'w_down': nrm(ks[15], (DEPTH, N_EXPERTS, D_EXPERT, D_MODEL), D_EXPERT),
        'ple_norm': gain(ks[16], (DEPTH, D_MODEL)),
        'w_ple_gate': nrm(ks[17], (DEPTH, D_MODEL, D_MODEL), D_MODEL),
        'w_ple_proj': nrm(ks[18], (DEPTH, PLE_DIM, D_MODEL), PLE_DIM),
        'final_norm': gain(ks[19], (D_MODEL,)),
    }


def reference(x, p, attn_norm, w_in, b_forget, w_fox_branch, w_moba_branch, w_out,
              moe_norm, w_group, b_group, w_fine, b_fine, w_gate, w_up, w_down,
              ple_norm, w_ple_gate, w_ple_proj, final_norm):
    b, s, _ = x.shape
    split_at = [int(v) for v in np.cumsum([FOX_WIDTH] * 3 + [MOBA_WIDTH] * 3 + [N_FOX_HEADS, D_MODEL])]

    def heads(t, n):
        return t.reshape(b, s, n, HEAD_DIM).transpose(0, 2, 1, 3)

    def merge(t):
        return t.transpose(0, 2, 1, 3).reshape(b, s, -1)

    for i in range(DEPTH):
        h = rmsnorm(x, attn_norm[i])
        proj = jnp.einsum('bsd,dc->bsc', h, w_in[i])
        qf, kf, vf, qm, km, vm, f_logit, ga, gb = jnp.split(proj, split_at, axis=-1)
        log_f = jax.nn.log_sigmoid(f_logit.astype(jnp.float32) + b_forget[i].astype(jnp.float32))
        y_fox = forgetting_attention(heads(qf, N_FOX_HEADS), heads(kf, N_FOX_HEADS),
                                     heads(vf, N_FOX_HEADS), log_f.transpose(0, 2, 1))
        y_moba = moba_attention(rope(heads(qm, N_MOBA_HEADS)), rope(heads(km, N_MOBA_HEADS)),
                                heads(vm, N_MOBA_HEADS))
        ya = merge(y_fox) @ w_fox_branch[i]
        yb = merge(y_moba) @ w_moba_branch[i]
        mixed = jax.nn.sigmoid(ga) * ya + jax.nn.sigmoid(gb) * yb
        x = x + mixed @ w_out[i]
        h2 = rmsnorm(x, moe_norm[i])
        x = x + hierarchical_moe(h2, w_group[i], b_group[i], w_fine[i], b_fine[i],
                                 w_gate[i], w_up[i], w_down[i])
        g = jax.nn.sigmoid(rmsnorm(x, ple_norm[i]) @ w_ple_gate[i])
        x = x + g * (p[i] @ w_ple_proj[i])
    return rmsnorm(x, final_norm)
```

```cpp
#include <hip/hip_runtime.h>
#include <cstdio>
#include <cstdint>

#ifndef MK_N_LAUNCHES
#define MK_N_LAUNCHES 11
#endif

#define LAS __attribute__((address_space(3)))
typedef unsigned short bf16_t;
typedef short bf16x8 __attribute__((ext_vector_type(8)));
typedef short s16x4 __attribute__((ext_vector_type(4)));
typedef float f32x2 __attribute__((ext_vector_type(2)));
typedef float f32x4 __attribute__((ext_vector_type(4)));
typedef float f32x16 __attribute__((ext_vector_type(16)));
typedef unsigned u32x2 __attribute__((ext_vector_type(2)));
typedef unsigned u32x4 __attribute__((ext_vector_type(4)));
typedef __bf16 bf16x2_t __attribute__((ext_vector_type(2)));

constexpr int NB = 8, SEQ = 4096, T = NB * SEQ, DM = 1024, NH = 8, HD = 64, AW = 512, PLE = 256, NE = 32, DE = 512, INC = 5128;
constexpr int NPH = 11;
constexpr float RMS_EPS = 1e-6f;
constexpr float LOG2E = 1.4426950408889634f;
constexpr float QSCALE = 0.125f * LOG2E;

constexpr size_t MiB = 1u << 20;
constexpr size_t WS_CTL = 0, CTL_BYTES = 1 * MiB;
constexpr size_t WS_W1 = 1 * MiB;
constexpr size_t WS_WV = 9 * MiB;
constexpr size_t WS_WF = 11 * MiB;
constexpr size_t WS_WM = 12 * MiB;
constexpr size_t WS_WO = 13 * MiB;
constexpr size_t WS_WPG = 15 * MiB;
constexpr size_t WS_WPP = 17 * MiB;
constexpr size_t WS_WG = 18 * MiB;
constexpr size_t WS_WU = 50 * MiB;
constexpr size_t WS_WD = 82 * MiB;
constexpr size_t WS_COS = 114 * MiB;
constexpr size_t WS_SIN = WS_COS + 512 * 1024;
constexpr size_t WS_LOGF = 115 * MiB;
constexpr size_t WS_C2 = 116 * MiB;
constexpr size_t WS_KMP = 117 * MiB;
constexpr size_t WS_RSTD2 = 118 * MiB;
constexpr size_t WS_RSTD3 = WS_RSTD2 + 128 * 1024;
constexpr size_t WS_TOKW = WS_RSTD3 + 128 * 1024;
constexpr size_t WS_LISTS = 119 * MiB;
constexpr size_t WS_HB = 128 * MiB;
constexpr size_t WS_QF = 192 * MiB, WS_KF = 224 * MiB, WS_QM = 256 * MiB, WS_KM = 288 * MiB;
constexpr size_t WS_CONTRIB = 192 * MiB;
constexpr size_t WS_VT = 320 * MiB;
constexpr size_t WS_MIXED = 320 * MiB, WS_PB = 320 * MiB;
constexpr size_t WS_SA = 384 * MiB, WS_SB = 448 * MiB;
constexpr size_t WS_HBUF = 384 * MiB;
constexpr size_t WS_END = 512 * MiB;

constexpr int CW_ATTCTR = 8;
constexpr int CW_CNT = 64;
constexpr int CW_BAR = 4096;

constexpr int LDS_BYTES = 147456;
constexpr int MISC_OFF = 131072;

__device__ __forceinline__ unsigned pk2(float lo, float hi) { f32x2 v = {lo, hi}; bf16x2_t b = __builtin_convertvector(v, bf16x2_t); return __builtin_bit_cast(unsigned, b); }
__device__ __forceinline__ float bflo(unsigned u) { return __builtin_bit_cast(float, u << 16); }
__device__ __forceinline__ float bfhi(unsigned u) { return __builtin_bit_cast(float, u & 0xffff0000u); }
__device__ __forceinline__ float bf2f(short s) { return __builtin_bit_cast(float, ((unsigned)(unsigned short)s) << 16); }
__device__ __forceinline__ float wave_sum(float v) {
#pragma unroll
    for (int o = 1; o < 64; o <<= 1) v += __shfl_xor(v, o);
    return v;
}
__device__ __forceinline__ float sigmoidf_(float x) { return 1.0f / (1.0f + __expf(-x)); }

#define EPI_FENCE() asm volatile("" ::: "memory")
#define XB_TMO      128
#define XB_XCNT(j)  (256  + 64 * (j))
#define XB_XSUB(j)  (1280 + 64 * (j))
#define XB_XGEN(j)  (2304 + 64 * (j))
#define XB_TOP      3328
#define XB_TOPGEN   3392
#define XCD_BAR_WORDS 3456
#define XB_SPIN_CAP (1u << 22)
__device__ __forceinline__ unsigned xb_ld(unsigned* p)              { return __hip_atomic_load(p, __ATOMIC_RELAXED, __HIP_MEMORY_SCOPE_AGENT); }
__device__ __forceinline__ unsigned xb_add(unsigned* p, unsigned v) { return __hip_atomic_fetch_add(p, v, __ATOMIC_RELAXED, __HIP_MEMORY_SCOPE_AGENT); }
__device__ __forceinline__ unsigned xb_xcc_id() { return (unsigned)__builtin_amdgcn_s_getreg((3 << 11) | 20) & 0xFu; }
#define XB_SPIN(cond, bar) do { unsigned _sp = 0; while (cond) { __builtin_amdgcn_s_sleep(1); \
    if ((++_sp & 255u) == 0u) { if (xb_ld(&(bar)[XB_TMO])) break; if (_sp > XB_SPIN_CAP) { atomicAdd(&(bar)[XB_TMO], 1u); break; } } } } while (0)
struct XcdBarrier { unsigned* bar; unsigned x; volatile LAS unsigned* st; };
__device__ __forceinline__ XcdBarrier xcd_barrier_post(unsigned* bar, volatile LAS unsigned* st) {
    XcdBarrier b; b.bar = bar; b.x = xb_xcc_id(); b.st = st;
    if (threadIdx.x == 0) (void)xb_add(&bar[XB_XCNT(b.x)], 1u);
    return b;
}
__device__ __forceinline__ void xcd_barrier_complete(unsigned* bar, unsigned x, unsigned& nloc, unsigned& nx) {
    const unsigned G = gridDim.x * gridDim.y * gridDim.z;
    unsigned sum, cnt, mine, sp = 0u;
    for (;;) {
        sum = 0u; cnt = 0u; mine = 0u;
#pragma unroll
        for (unsigned j = 0; j < 16; ++j) { const unsigned c = xb_ld(&bar[XB_XCNT(j)]); sum += c; cnt += (c > 0u) ? 1u : 0u; mine = (j == x) ? c : mine; }
        if (sum == G) break;
        __builtin_amdgcn_s_sleep(1);
        if ((++sp & 255u) == 0u) { if (xb_ld(&bar[XB_TMO])) break; if (sp > XB_SPIN_CAP) { atomicAdd(&bar[XB_TMO], 1u); break; } }
    }
    nloc = mine > 0u ? mine : 1u; nx = cnt > 0u ? cnt : 1u;
}
__device__ __forceinline__ void xcd_barrier(const XcdBarrier& b) {
    asm volatile("s_waitcnt vmcnt(0)" ::: "memory");
    __syncthreads();
    if (threadIdx.x == 0) {
        unsigned* bar = b.bar;
        __builtin_amdgcn_s_waitcnt(0);
        unsigned nloc = b.st[0], nx = b.st[1];
        if (nloc == 0u) { xcd_barrier_complete(bar, b.x, nloc, nx); b.st[0] = nloc; b.st[1] = nx; }
        const unsigned old = xb_add(&bar[XB_XSUB(b.x)], 1u);
        const unsigned gen = old / nloc;
        if (old + 1u == (gen + 1u) * nloc) {
            __builtin_amdgcn_fence(__ATOMIC_RELEASE, "agent");
            asm volatile("s_waitcnt vmcnt(0)" ::: "memory");
            const unsigned og = xb_add(&bar[XB_TOP], 1u);
            const unsigned tg = og / nx;
            if (og + 1u == (tg + 1u) * nx) xb_add(&bar[XB_TOPGEN], 1u);
            else XB_SPIN(xb_ld(&bar[XB_TOPGEN]) == tg, bar);
            __builtin_amdgcn_fence(__ATOMIC_ACQUIRE, "agent");
            xb_add(&bar[XB_XGEN(b.x)], 1u);
            asm volatile("s_waitcnt vmcnt(0)" ::: "memory");
        } else {
            XB_SPIN(xb_ld(&bar[XB_XGEN(b.x)]) == gen, bar);
            __builtin_amdgcn_fence(__ATOMIC_ACQUIRE, "agent");
            asm volatile("s_waitcnt vmcnt(0)" ::: "memory");
        }
    }
    __syncthreads();
}

struct Args {
    const float* in[20];
    float* out;
    unsigned char* ws;
    int ph_lo, ph_hi;
};

struct Ctx {
    LAS unsigned char* lds;
    int tid, lane, wave, vcu, G;
};

struct GSrc { const char* abase; unsigned aoff[4]; const char* bbase0; const char* bbase1; unsigned boff[2]; };

typedef f32x4 Acc[2][2][4][2];

__device__ __forceinline__ void acc_zero(Acc& acc) {
#pragma unroll
    for (int a = 0; a < 2; ++a)
#pragma unroll
        for (int b = 0; b < 2; ++b)
#pragma unroll
            for (int m = 0; m < 4; ++m)
#pragma unroll
                for (int n = 0; n < 2; ++n) acc[a][b][m][n] = (f32x4){0.f, 0.f, 0.f, 0.f};
}

template <bool H0, bool H1>
__device__ __forceinline__ void g_load(const GSrc& s, unsigned kb, u32x4 (&ra)[4], u32x4 (&rb)[4]) {
#pragma unroll
    for (int i = 0; i < 4; ++i) ra[i] = *(const u32x4*)(s.abase + s.aoff[i] + kb);
    if (H0) {
#pragma unroll
        for (int i = 0; i < 2; ++i) rb[i] = *(const u32x4*)(s.bbase0 + s.boff[i] + kb);
    }
    if (H1) {
#pragma unroll
        for (int i = 0; i < 2; ++i) rb[2 + i] = *(const u32x4*)(s.bbase1 + s.boff[i] + kb);
    }
}
template <bool H0, bool H1>
__device__ __forceinline__ void g_store(LAS unsigned char* buf, int woff, const u32x4 (&ra)[4], const u32x4 (&rb)[4]) {
#pragma unroll
    for (int i = 0; i < 4; ++i) *(LAS u32x4*)(buf + woff + i * 8192) = ra[i];
    if (H0) {
#pragma unroll
        for (int i = 0; i < 2; ++i) *(LAS u32x4*)(buf + 32768 + woff + i * 8192) = rb[i];
    }
    if (H1) {
#pragma unroll
        for (int i = 0; i < 2; ++i) *(LAS u32x4*)(buf + 32768 + 16384 + woff + i * 8192) = rb[2 + i];
    }
}
template <bool H0, bool H1>
__device__ __forceinline__ void g_mma(LAS const unsigned char* buf, Acc& acc, int aoffL, int boffL) {
#pragma unroll
    for (int s = 0; s < 2; ++s) {
        bf16x8 bfr[2][2];
#pragma unroll
        for (int bj = 0; bj < 2; ++bj) {
            if ((bj == 0 && !H0) || (bj == 1 && !H1)) continue;
#pragma unroll
            for (int n = 0; n < 2; ++n) bfr[bj][n] = *(LAS const bf16x8*)(buf + 32768 + ((boffL + bj * 16384 + n * 2048) ^ (s * 64)));
        }
#pragma unroll
        for (int ai = 0; ai < 2; ++ai) {
            bf16x8 af[4];
#pragma unroll
            for (int m = 0; m < 4; ++m) af[m] = *(LAS const bf16x8*)(buf + ((aoffL + ai * 16384 + m * 2048) ^ (s * 64)));
#pragma unroll
            for (int bj = 0; bj < 2; ++bj) {
                if ((bj == 0 && !H0) || (bj == 1 && !H1)) continue;
#pragma unroll
                for (int m = 0; m < 4; ++m)
#pragma unroll
                    for (int n = 0; n < 2; ++n)
                        acc[ai][bj][m][n] = __builtin_amdgcn_mfma_f32_16x16x32_bf16(bfr[bj][n], af[m], acc[ai][bj][m][n], 0, 0, 0);
            }
        }
    }
}

__device__ __forceinline__ void gemm_full(const Ctx& C, Acc& acc, const GSrc& s, int K) {
    int tid = C.tid; asm volatile("" : "+v"(tid)); const int lane = tid & 63, wr = C.wave >> 2, wc = C.wave & 3, fr = lane & 15, fq = lane >> 4;
    const int wrow = tid >> 3, wch = tid & 7;
    const int woff = wrow * 128 + ((wch ^ ((wrow >> 1) & 7)) * 16);
    const int aoffL = (64 * wr + fr) * 128 + ((fq ^ (fr >> 1)) * 16);
    const int boffL = (32 * wc + fr) * 128 + ((fq ^ (fr >> 1)) * 16);
    const int nk = K >> 6;
    u32x4 ra[4], rb[4];
    g_load<true, true>(s, 0u, ra, rb);
    g_store<true, true>(C.lds, woff, ra, rb);
    __syncthreads();
    for (int kt = 0; kt < nk; ++kt) {
        LAS unsigned char* cur = C.lds + (kt & 1) * 65536;
        LAS unsigned char* nxt = C.lds + ((kt & 1) ^ 1) * 65536;
        const bool more = (kt + 1 < nk);
        if (more) g_load<true, true>(s, (unsigned)(kt + 1) * 128u, ra, rb);
        g_mma<true, true>(cur, acc, aoffL, boffL);
        if (more) g_store<true, true>(nxt, woff, ra, rb);
        __syncthreads();
    }
}
__device__ __forceinline__ void gemm_split(const Ctx& C, Acc& acc, const GSrc& s0, int K0, const GSrc& s1, int K1) {
    int tid = C.tid; asm volatile("" : "+v"(tid)); const int lane = tid & 63, wr = C.wave >> 2, wc = C.wave & 3, fr = lane & 15, fq = lane >> 4;
    const int wrow = tid >> 3, wch = tid & 7;
    const int woff = wrow * 128 + ((wch ^ ((wrow >> 1) & 7)) * 16);
    const int aoffL = (64 * wr + fr) * 128 + ((fq ^ (fr >> 1)) * 16);
    const int boffL = (32 * wc + fr) * 128 + ((fq ^ (fr >> 1)) * 16);
    const int n0 = K0 >> 6, nk = n0 + (K1 >> 6);
    u32x4 ra[4], rb[4];
    g_load<true, false>(s0, 0u, ra, rb);
    g_store<true, false>(C.lds, woff, ra, rb);
    __syncthreads();
    for (int kt = 0; kt < nk; ++kt) {
        LAS unsigned char* cur = C.lds + (kt & 1) * 65536;
        LAS unsigned char* nxt = C.lds + ((kt & 1) ^ 1) * 65536;
        const bool more = (kt + 1 < nk);
        const bool nx0 = (kt + 1 < n0);
        if (more) { if (nx0) g_load<true, false>(s0, (unsigned)(kt + 1) * 128u, ra, rb); else g_load<false, true>(s1, (unsigned)(kt + 1 - n0) * 128u, ra, rb); }
        if (kt < n0) g_mma<true, false>(cur, acc, aoffL, boffL); else g_mma<false, true>(cur, acc, aoffL, boffL);
        if (more) { if (nx0) g_store<true, false>(nxt, woff, ra, rb); else g_store<false, true>(nxt, woff, ra, rb); }
        __syncthreads();
    }
}

__device__ __forceinline__ void p0_item(const float* W, int ldw, int n0, int k0, bf16_t* dst, int v0, int dpitch, const float* gain, LAS float* scr, int lane) {
#pragma unroll 8
    for (int i = 0; i < 32; ++i) { const int kk = 2 * i + (lane >> 5); float v = W[(size_t)(k0 + kk) * ldw + n0 + (lane & 31)]; if (gain) v *= gain[k0 + kk]; scr[kk * 33 + (lane & 31)] = v; }
    asm volatile("s_waitcnt lgkmcnt(0)" ::: "memory");
    const int c = lane & 7;
#pragma unroll
    for (int j = 0; j < 4; ++j) { const int n = (lane >> 3) + 8 * j; const LAS float* s = scr + (8 * c) * 33 + n;
        u32x4 o; o.x = pk2(s[0 * 33], s[1 * 33]); o.y = pk2(s[2 * 33], s[3 * 33]); o.z = pk2(s[4 * 33], s[5 * 33]); o.w = pk2(s[6 * 33], s[7 * 33]);
        *(u32x4*)(dst + (size_t)(v0 + n) * dpitch + k0 + 8 * c) = o; }
    asm volatile("s_waitcnt lgkmcnt(0)" ::: "memory");
}

__device__ __forceinline__ void phase0(const Ctx& C, const Args& a) {
    unsigned char* ws = a.ws;
    const int gw = C.vcu * 8 + C.wave, NGW = C.G * 8;
    LAS float* wfl = (LAS float*)(C.lds + 73728);
    for (int idx = C.tid; idx < 8192; idx += 512) { const int k = idx >> 3, c = idx & 7; wfl[c * 1024 + k] = a.in[3][(size_t)k * INC + 3072 + c]; }
    __syncthreads();
    {
        const float* g = a.in[2]; const float* bfg = a.in[4];
        bf16_t* HB = (bf16_t*)(ws + WS_HB); float* LOGF = (float*)(ws + WS_LOGF);
        f32x4 gv[4];
#pragma unroll
        for (int j = 0; j < 4; ++j) gv[j] = *(const f32x4*)(g + 4 * C.lane + 256 * j);
        for (int t = gw; t < T; t += NGW) {
            const f32x4* xr = (const f32x4*)(a.in[0] + (size_t)t * DM) + C.lane;
            f32x4 v[4]; float ss = 0.f;
#pragma unroll
            for (int j = 0; j < 4; ++j) { v[j] = xr[64 * j]; ss += (v[j].x * v[j].x + v[j].y * v[j].y) + (v[j].z * v[j].z + v[j].w * v[j].w); }
            const float rstd = 1.0f / sqrtf(wave_sum(ss) * (1.0f / DM) + RMS_EPS);
            unsigned long long* o8 = (unsigned long long*)(HB + (size_t)t * DM) + C.lane;
#pragma unroll
            for (int j = 0; j < 4; ++j) { v[j] = v[j] * rstd * gv[j]; o8[64 * j] = (unsigned long long)pk2(v[j].x, v[j].y) | ((unsigned long long)pk2(v[j].z, v[j].w) << 32); }
            float fl[8];
#pragma unroll
            for (int c = 0; c < 8; ++c) { float s = 0.f;
#pragma unroll
                for (int j = 0; j < 4; ++j) { const f32x4 w = *(LAS const f32x4*)(wfl + c * 1024 + 4 * C.lane + 256 * j); s += (v[j].x * w.x + v[j].y * w.y) + (v[j].z * w.z + v[j].w * w.w); }
                fl[c] = wave_sum(s); }
            if (C.lane < 8) {
                float z = 0.f;
#pragma unroll
                for (int c = 0; c < 8; ++c) z = (C.lane == c) ? fl[c] : z;
                z += bfg[C.lane];
                const float ls = (z >= 0.f) ? -log1pf(expf(-z)) : (z - log1pf(expf(z)));
                const int b = t >> 12, s_ = t & 4095;
                LOGF[(size_t)(b * 8 + C.lane) * SEQ + s_] = ls;
            }
        }
    }
    {
        float* COS = (float*)(ws + WS_COS); float* SIN = (float*)(ws + WS_SIN);
        for (int idx = C.vcu * 512 + C.tid; idx < SEQ * 32; idx += C.G * 512) {
            const int pos = idx >> 5, i = idx & 31;
            const double inv = exp(-(double)i * (1.0 / 32.0) * 9.210340371976184);
            const double ang = (double)pos * inv;
            double sn, cs; sincos(ang, &sn, &cs);
            COS[idx] = (float)cs; SIN[idx] = (float)sn;
        }
    }
    {
        LAS float* scr = (LAS float*)(C.lds + C.wave * 8704);
        const int I_W1 = 16 * 128, I_WV = 16 * 32, I_WF = 8 * 32, I_WM = 8 * 32, I_WO = 16 * 32, I_WPG = 16 * 32, I_WPP = 4 * 32, I_GU = 32 * 16 * 16, I_D = 32 * 8 * 32;
        const int NIT = I_W1 + I_WV + I_WF + I_WM + I_WO + I_WPG + I_WPP + 2 * I_GU + I_D;
        for (int it = gw; it < NIT; it += NGW) {
            int r = it;
            if (r < I_W1) { const int kb = r >> 7, nb = r & 127, v0 = nb * 32; int src;
                if (v0 < 1024) src = v0;
                else if (v0 < 2048) { const int u = v0 - 1024, sec = u >> 9, uu = u & 511, tile = uu >> 8, w = uu & 255, bj = w >> 7, u2 = w & 127;
                    src = 1536 + sec * 512 + tile * 256 + (u2 >> 5) * 64 + bj * 32 + (u2 & 31); }
                else if (v0 < 3072) src = 3080 + (v0 - 2048);
                else src = 4104 + (v0 - 3072);
                p0_item(a.in[3], INC, src, kb * 64, (bf16_t*)(ws + WS_W1), v0, 1024, nullptr, scr, C.lane); continue; } r -= I_W1;
            if (r < I_WV) { const int kb = r >> 5, nb = r & 31, v0 = nb * 32; const int src = (v0 < 512) ? (1024 + v0) : (2560 + (v0 - 512));
                p0_item(a.in[3], INC, src, kb * 64, (bf16_t*)(ws + WS_WV), v0, 1024, nullptr, scr, C.lane); continue; } r -= I_WV;
            if (r < I_WF) { const int kb = r >> 5, nb = r & 31; p0_item(a.in[5], 1024, nb * 32, kb * 64, (bf16_t*)(ws + WS_WF), nb * 32, 512, nullptr, scr, C.lane); continue; } r -= I_WF;
            if (r < I_WM) { const int kb = r >> 5, nb = r & 31; p0_item(a.in[6], 1024, nb * 32, kb * 64, (bf16_t*)(ws + WS_WM), nb * 32, 512, nullptr, scr, C.lane); continue; } r -= I_WM;
            if (r < I_WO) { const int kb = r >> 5, nb = r & 31; p0_item(a.in[7], 1024, nb * 32, kb * 64, (bf16_t*)(ws + WS_WO), nb * 32, 1024, nullptr, scr, C.lane); continue; } r -= I_WO;
            if (r < I_WPG) { const int kb = r >> 5, nb = r & 31; p0_item(a.in[17], 1024, nb * 32, kb * 64, (bf16_t*)(ws + WS_WPG), nb * 32, 1024, a.in[16], scr, C.lane); continue; } r -= I_WPG;
            if (r < I_WPP) { const int kb = r >> 5, nb = r & 31; p0_item(a.in[18], 1024, nb * 32, kb * 64, (bf16_t*)(ws + WS_WPP), nb * 32, 256, nullptr, scr, C.lane); continue; } r -= I_WPP;
            if (r < I_GU) { const int e = r >> 8, q = r & 255, kb = q >> 4, nb = q & 15;
                p0_item(a.in[13] + (size_t)e * DM * DE, DE, nb * 32, kb * 64, (bf16_t*)(ws + WS_WG) + (size_t)e * DE * DM, nb * 32, 1024, a.in[8], scr, C.lane); continue; } r -= I_GU;
            if (r < I_GU) { const int e = r >> 8, q = r & 255, kb = q >> 4, nb = q & 15;
                p0_item(a.in[14] + (size_t)e * DM * DE, DE, nb * 32, kb * 64, (bf16_t*)(ws + WS_WU) + (size_t)e * DE * DM, nb * 32, 1024, a.in[8], scr, C.lane); continue; } r -= I_GU;
            { const int e = r >> 8, q = r & 255, kb = q >> 5, nb = q & 31;
                p0_item(a.in[15] + (size_t)e * DE * DM, DM, nb * 32, kb * 64, (bf16_t*)(ws + WS_WD) + (size_t)e * DM * DE, nb * 32, 512, nullptr, scr, C.lane); }
        }
    }
}

__device__ __forceinline__ void p1_cumsum(const Ctx& C, const Args& a) {
    if (C.vcu < 64 && C.wave == 0) {
        const float* LOGF = (const float*)(a.ws + WS_LOGF) + (size_t)C.vcu * SEQ; float* C2 = (float*)(a.ws + WS_C2) + (size_t)C.vcu * SEQ;
        double loc = 0.0;
        for (int i = 0; i < 64; ++i) loc += (double)LOGF[C.lane * 64 + i];
        double inc = loc;
#pragma unroll
        for (int o = 1; o < 64; o <<= 1) { const double nb = __shfl_up(inc, o); if (C.lane >= o) inc += nb; }
        double run = inc - loc;
        for (int i = 0; i < 64; ++i) { run += (double)LOGF[C.lane * 64 + i]; C2[C.lane * 64 + i] = (float)(run * 1.4426950408889634); }
    }
}

template <bool ISK>
__device__ __forceinline__ void rope_epi(const Args& a, Acc& acc, int pm, int pn, int rowt, int wr, int wc, int fr, int fq) {
    unsigned char* ws = a.ws;
    bf16_t* O = (bf16_t*)(ws + (ISK ? WS_KM : WS_QM)); const float sc = ISK ? 1.0f : QSCALE;
    const float* COS = (const float*)(ws + WS_COS); const float* SIN = (const float*)(ws + WS_SIN);
    const int head = 4 * (pn & 1) + wc;
    f32x4 cs1[2] = {{0.f, 0.f, 0.f, 0.f}, {0.f, 0.f, 0.f, 0.f}}, cs2[2] = {{0.f, 0.f, 0.f, 0.f}, {0.f, 0.f, 0.f, 0.f}};
#pragma unroll
    for (int ai = 0; ai < 2; ++ai)
#pragma unroll
        for (int m = 0; m < 4; ++m) { const int row = rowt + 128 * ai + 16 * m; const int pos = row & (SEQ - 1);
            bf16_t* rp = O + (size_t)row * AW + head * 64 + 4 * fq;
#pragma unroll
            for (int n = 0; n < 2; ++n) { const f32x4 co = *(const f32x4*)(COS + pos * 32 + 16 * n + 4 * fq), si = *(const f32x4*)(SIN + pos * 32 + 16 * n + 4 * fq);
                const f32x4 x1 = acc[ai][0][m][n], x2 = acc[ai][1][m][n];
                const f32x4 o1 = x1 * co - x2 * si, o2 = x2 * co + x1 * si;
                if (ISK) { cs1[n] += o1; cs2[n] += o2; asm volatile("" : "+v"(cs1[n]), "+v"(cs2[n])); }
                const f32x4 w1 = o1 * sc, w2 = o2 * sc;
                *(u32x2*)(rp + 16 * n) = (u32x2){pk2(w1.x, w1.y), pk2(w1.z, w1.w)};
                *(u32x2*)(rp + 32 + 16 * n) = (u32x2){pk2(w2.x, w2.y), pk2(w2.z, w2.w)}; }
            EPI_FENCE(); }
    if (ISK) {
        float* KMP = (float*)(ws + WS_KMP) + (size_t)(pm * 2 + wr) * 512 + head * 64;
#pragma unroll
        for (int n = 0; n < 2; ++n)
#pragma unroll
            for (int j = 0; j < 4; ++j) { float v1 = cs1[n][j], v2 = cs2[n][j];
#pragma unroll
                for (int o = 1; o < 16; o <<= 1) { v1 += __shfl_xor(v1, o); v2 += __shfl_xor(v2, o); }
                if (fr == 0) { KMP[16 * n + 4 * fq + j] = v1; KMP[32 + 16 * n + 4 * fq + j] = v2; }
                EPI_FENCE(); }
    }
}

__device__ __forceinline__ void p1_unit_proj(const Ctx& C, const Args& a, int pm, int pn) {
    unsigned char* ws = a.ws;
    int tid = C.tid; asm volatile("" : "+v"(tid)); const int lane = tid & 63, wr = C.wave >> 2, wc = C.wave & 3, fr = lane & 15, fq = lane >> 4;
    GSrc s; s.abase = (const char*)(ws + WS_HB); s.bbase0 = (const char*)(ws + WS_W1) + (size_t)(pn * 256) * 2048; s.bbase1 = s.bbase0 + (size_t)128 * 2048;
#pragma unroll
    for (int i = 0; i < 4; ++i) s.aoff[i] = (unsigned)((pm * 256 + (tid >> 3) + 64 * i) * 2048 + (tid & 7) * 16);
#pragma unroll
    for (int i = 0; i < 2; ++i) s.boff[i] = (unsigned)(((tid >> 3) + 64 * i) * 2048 + (tid & 7) * 16);
    Acc acc; acc_zero(acc);
    gemm_full(C, acc, s, 1024);
    const int rowt = pm * 256 + 64 * wr + fr;
    if (pn < 4) {
        bf16_t* O = (bf16_t*)(ws + (pn < 2 ? WS_QF : WS_KF)); const float sc = (pn < 2) ? QSCALE : 1.0f; const int cb = (pn & 1) * 256 + 32 * wc + 4 * fq;
#pragma unroll
        for (int ai = 0; ai < 2; ++ai)
#pragma unroll
            for (int m = 0; m < 4; ++m) { bf16_t* rp = O + (size_t)(rowt + 128 * ai + 16 * m) * AW + cb;
#pragma unroll
                for (int bj = 0; bj < 2; ++bj)
#pragma unroll
                    for (int n = 0; n < 2; ++n) { const f32x4 v = acc[ai][bj][m][n] * sc; *(u32x2*)(rp + 128 * bj + 16 * n) = (u32x2){pk2(v.x, v.y), pk2(v.z, v.w)}; } EPI_FENCE(); }
    } else if (pn < 6) { rope_epi<false>(a, acc, pm, pn, rowt, wr, wc, fr, fq);
    } else if (pn < 8) { rope_epi<true>(a, acc, pm, pn, rowt, wr, wc, fr, fq);
    } else {
        bf16_t* O = (bf16_t*)(ws + (pn < 12 ? WS_SA : WS_SB)); const int cb = ((pn - 8) & 3) * 256 + 32 * wc + 4 * fq;
#pragma unroll
        for (int ai = 0; ai < 2; ++ai)
#pragma unroll
            for (int m = 0; m < 4; ++m) { bf16_t* rp = O + (size_t)(rowt + 128 * ai + 16 * m) * DM + cb;
#pragma unroll
                for (int bj = 0; bj < 2; ++bj)
#pragma unroll
                    for (int n = 0; n < 2; ++n) { const f32x4 v = acc[ai][bj][m][n];
                        *(u32x2*)(rp + 128 * bj + 16 * n) = (u32x2){pk2(sigmoidf_(v.x), sigmoidf_(v.y)), pk2(sigmoidf_(v.z), sigmoidf_(v.w))}; } EPI_FENCE(); }
    }
}
__device__ __forceinline__ void p1_unit_vt(const Ctx& C, const Args& a, int pmf, int pnt) {
    unsigned char* ws = a.ws;
    int tid = C.tid; asm volatile("" : "+v"(tid)); const int lane = tid & 63, wr = C.wave >> 2, wc = C.wave & 3, fr = lane & 15, fq = lane >> 4;
    GSrc s; s.abase = (const char*)(ws + WS_WV); s.bbase0 = (const char*)(ws + WS_HB) + (size_t)(pnt * 256) * 2048; s.bbase1 = s.bbase0 + (size_t)128 * 2048;
#pragma unroll
    for (int i = 0; i < 4; ++i) s.aoff[i] = (unsigned)((pmf * 256 + (tid >> 3) + 64 * i) * 2048 + (tid & 7) * 16);
#pragma unroll
    for (int i = 0; i < 2; ++i) s.boff[i] = (unsigned)(((tid >> 3) + 64 * i) * 2048 + (tid & 7) * 16);
    Acc acc; acc_zero(acc);
    gemm_full(C, acc, s, 1024);
    bf16_t* VT = (bf16_t*)(ws + WS_VT);
    const int tok0 = pnt * 256, b = tok0 >> 12, s0 = (tok0 & (SEQ - 1)) + 32 * wc + 4 * fq;
#pragma unroll
    for (int ai = 0; ai < 2; ++ai)
#pragma unroll
        for (int m = 0; m < 4; ++m) { const int f = pmf * 256 + 128 * ai + 64 * wr + 16 * m + fr; const int type = f >> 9, hh = (f >> 6) & 7, d = f & 63;
            bf16_t* rp = VT + ((size_t)((type * 8 + b) * 8 + hh) * 64 + d) * SEQ + s0;
#pragma unroll
            for (int bj = 0; bj < 2; ++bj)
#pragma unroll
                for (int n = 0; n < 2; ++n) { const f32x4 v = acc[ai][bj][m][n]; *(u32x2*)(rp + 128 * bj + 16 * n) = (u32x2){pk2(v.x, v.y), pk2(v.z, v.w)}; } EPI_FENCE(); }
}

constexpr int AL_K = 0, AL_V = 16384, AL_C = 33792, AL_V_STRIDE = 136, AL_VB = 8704;
__device__ __forceinline__ void attn_unit(const Ctx& C, const Args& a, int type, int bh, int qb) {
    unsigned char* ws = a.ws;
    const int tid = C.tid, lane = C.lane, wid = C.wave, q32 = lane & 31, hi = lane >> 5;
    const int b = bh >> 3, h = bh & 7;
    const bf16_t* Q = (const bf16_t*)(ws + (type ? WS_QM : WS_QF));
    const bf16_t* K = (const bf16_t*)(ws + (type ? WS_KM : WS_KF));
    const bf16_t* VT = (const bf16_t*)(ws + WS_VT) + (size_t)(type * 64 + bh) * 64 * SEQ;
    const float* C2 = (const float*)(ws + WS_C2) + (size_t)bh * SEQ;
    const size_t rowbase = (size_t)b * SEQ;
    const int q0 = qb * 256 + wid * 32, qpos = q0 + q32;
    bf16x8 qf[4];
    { const bf16_t* qp = Q + (rowbase + qpos) * AW + h * 64 + hi * 8;
#pragma unroll
      for (int ks = 0; ks < 4; ++ks) qf[ks] = *(const bf16x8*)(qp + ks * 16); }
    unsigned sel = 0u;
    if (type == 1) {
        if (qb <= 3) sel = (1u << qb) - 1u;
        else {
            float v1 = -INFINITY, v2 = -INFINITY, v3 = -INFINITY; int i1 = 0, i2 = 0, i3 = 0;
            for (int n = 0; n < qb; ++n) {
                const float* km0 = (const float*)(ws + WS_KMP) + (size_t)((b * 16 + n) * 2) * 512 + h * 64 + hi * 8;
                float g = 0.f;
#pragma unroll
                for (int ks = 0; ks < 4; ++ks) { const f32x4 ka = *(const f32x4*)(km0 + ks * 16) + *(const f32x4*)(km0 + 512 + ks * 16), kb = *(const f32x4*)(km0 + ks * 16 + 4) + *(const f32x4*)(km0 + 512 + ks * 16 + 4);
                    g += bf2f(qf[ks][0]) * ka.x + bf2f(qf[ks][1]) * ka.y + bf2f(qf[ks][2]) * ka.z + bf2f(qf[ks][3]) * ka.w
                       + bf2f(qf[ks][4]) * kb.x + bf2f(qf[ks][5]) * kb.y + bf2f(qf[ks][6]) * kb.z + bf2f(qf[ks][7]) * kb.w; }
                g += __shfl_xor(g, 32);
                if (g > v1) { v3 = v2; i3 = i2; v2 = v1; i2 = i1; v1 = g; i1 = n; }
                else if (g > v2) { v3 = v2; i3 = i2; v2 = g; i2 = n; }
                else if (g > v3) { v3 = g; i3 = n; }
            }
            sel = (1u << i1) | (1u << i2) | (1u << i3);
        }
    }
    const float cq = (type == 0) ? C2[qpos] : 0.f;
    const int nt = 4 * (qb + 1);
    const int lrow = tid >> 3, lch = tid & 7;
    const bf16_t* ksrc = K + (rowbase + lrow) * AW + h * 64 + lch * 8;
    const bf16_t* vsrc = VT + (size_t)lrow * SEQ + lch * 8;
    const int kwoff = lrow * 128 + ((lch ^ ((lrow >> 1) & 7)) * 16);
    const int vwoff = lrow * AL_V_STRIDE + lch * 16;
    LAS unsigned char* L = C.lds;
    u32x4 rk, rv; float rc = 0.f;
    rk = *(const u32x4*)(ksrc); rv = *(const u32x4*)(vsrc); if (type == 0 && tid < 64) rc = C2[tid];
    *(LAS u32x4*)(L + AL_K + kwoff) = rk; *(LAS u32x2*)(L + AL_V + vwoff) = (u32x2){rv.x, rv.y}; *(LAS u32x2*)(L + AL_V + vwoff + 8) = (u32x2){rv.z, rv.w};
    if (type == 0 && tid < 64) *(LAS float*)(L + AL_C + tid * 4) = rc;
    __syncthreads();
    float mrun = -INFINITY, lrun = 0.f;
    f32x16 o0 = {0.f, 0.f, 0.f, 0.f, 0.f, 0.f, 0.f, 0.f, 0.f, 0.f, 0.f, 0.f, 0.f, 0.f, 0.f, 0.f}, o1 = o0;
    const int kroff = q32 * 128, ksw = (q32 >> 1) & 7;
    for (int t = 0; t < nt; ++t) {
        const int cur = t & 1; const bool more = (t + 1 < nt);
        const int kv0 = t * 64;
        if (more) { rk = *(const u32x4*)(ksrc + (size_t)(kv0 + 64) * AW); rv = *(const u32x4*)(vsrc + kv0 + 64); if (type == 0 && tid < 64) rc = C2[kv0 + 64 + tid]; }
        if (kv0 <= q0 + 31) {
            LAS const unsigned char* Kb = L + AL_K + cur * 8192; LAS const unsigned char* Vb = L + AL_V + cur * AL_VB; LAS const float* Cb = (LAS const float*)(L + AL_C + cur * 256);
            f32x16 p0 = {0.f, 0.f, 0.f, 0.f, 0.f, 0.f, 0.f, 0.f, 0.f, 0.f, 0.f, 0.f, 0.f, 0.f, 0.f, 0.f}, p1 = p0;
#pragma unroll
            for (int ks = 0; ks < 4; ++ks) {
                const bf16x8 ka = *(LAS const bf16x8*)(Kb + kroff + (((2 * ks + hi) ^ ksw) * 16));
                const bf16x8 kb = *(LAS const bf16x8*)(Kb + 4096 + kroff + (((2 * ks + hi) ^ ksw) * 16));
                p0 = __builtin_amdgcn_mfma_f32_32x32x16_bf16(ka, qf[ks], p0, 0, 0, 0);
                p1 = __builtin_amdgcn_mfma_f32_32x32x16_bf16(kb, qf[ks], p1, 0, 0, 0);
            }
            if (type == 0) {
#pragma unroll
                for (int g = 0; g < 4; ++g) { const f32x4 c0 = *(LAS const f32x4*)(Cb + 8 * g + 4 * hi), c1 = *(LAS const f32x4*)(Cb + 32 + 8 * g + 4 * hi);
#pragma unroll
                    for (int j = 0; j < 4; ++j) { p0[4 * g + j] += cq - c0[j]; p1[4 * g + j] += cq - c1[j]; } }
            }
            const bool diag = (kv0 + 63 > q0);
            const int nblk = kv0 >> 8;
            if (type == 1 && nblk < qb) {
                if (!((sel >> nblk) & 1u)) {
#pragma unroll
                    for (int r = 0; r < 16; ++r) { p0[r] = -INFINITY; p1[r] = -INFINITY; }
                }
            }
            if (diag) {
#pragma unroll
                for (int r = 0; r < 16; ++r) { const int kv = kv0 + (r & 3) + 8 * (r >> 2) + 4 * hi; if (kv > qpos) p0[r] = -INFINITY; if (kv + 32 > qpos) p1[r] = -INFINITY; }
            }
            float rm = p0[0];
#pragma unroll
            for (int r = 1; r < 16; ++r) rm = fmaxf(rm, p0[r]);
#pragma unroll
            for (int r = 0; r < 16; ++r) rm = fmaxf(rm, p1[r]);
            rm = fmaxf(rm, __shfl_xor(rm, 32));
            const float mnew = fmaxf(mrun, rm);
            const float muse = (mnew == -INFINITY) ? 0.f : mnew;
            const float alpha = __builtin_amdgcn_exp2f(mrun - muse);
            mrun = mnew;
            float psum = 0.f;
#pragma unroll
            for (int r = 0; r < 16; ++r) { p0[r] = __builtin_amdgcn_exp2f(p0[r] - muse); p1[r] = __builtin_amdgcn_exp2f(p1[r] - muse); psum += p0[r] + p1[r]; }
            lrun = lrun * alpha + psum;
#pragma unroll
            for (int r = 0; r < 16; ++r) { o0[r] *= alpha; o1[r] *= alpha; }
            bf16x8 pb[2][2];
#pragma unroll
            for (int s = 0; s < 2; ++s) {
                u32x4 w0 = {pk2(p0[8 * s + 0], p0[8 * s + 1]), pk2(p0[8 * s + 2], p0[8 * s + 3]), pk2(p0[8 * s + 4], p0[8 * s + 5]), pk2(p0[8 * s + 6], p0[8 * s + 7])};
                u32x4 w1 = {pk2(p1[8 * s + 0], p1[8 * s + 1]), pk2(p1[8 * s + 2], p1[8 * s + 3]), pk2(p1[8 * s + 4], p1[8 * s + 5]), pk2(p1[8 * s + 6], p1[8 * s + 7])};
                pb[0][s] = __builtin_bit_cast(bf16x8, w0); pb[1][s] = __builtin_bit_cast(bf16x8, w1);
            }
#pragma unroll
            for (int blk = 0; blk < 2; ++blk)
#pragma unroll
                for (int s = 0; s < 2; ++s) {
                    LAS const unsigned char* vp = Vb + q32 * AL_V_STRIDE + (32 * blk + 16 * s + 4 * hi) * 2;
                    const s16x4 a0 = *(LAS const s16x4*)(vp), a1 = *(LAS const s16x4*)(vp + 16);
                    const s16x4 c0 = *(LAS const s16x4*)(vp + 32 * AL_V_STRIDE), c1 = *(LAS const s16x4*)(vp + 32 * AL_V_STRIDE + 16);
                    const bf16x8 va = {a0[0], a0[1], a0[2], a0[3], a1[0], a1[1], a1[2], a1[3]};
                    const bf16x8 vc = {c0[0], c0[1], c0[2], c0[3], c1[0], c1[1], c1[2], c1[3]};
                    o0 = __builtin_amdgcn_mfma_f32_32x32x16_bf16(va, pb[blk][s], o0, 0, 0, 0);
                    o1 = __builtin_amdgcn_mfma_f32_32x32x16_bf16(vc, pb[blk][s], o1, 0, 0, 0);
                }
        }
        if (more) {
            const int nx = cur ^ 1;
            *(LAS u32x4*)(L + AL_K + nx * 8192 + kwoff) = rk;
            *(LAS u32x2*)(L + AL_V + nx * AL_VB + vwoff) = (u32x2){rv.x, rv.y}; *(LAS u32x2*)(L + AL_V + nx * AL_VB + vwoff + 8) = (u32x2){rv.z, rv.w};
            if (type == 0 && tid < 64) *(LAS float*)(L + AL_C + nx * 256 + tid * 4) = rc;
        }
        __syncthreads();
    }
    const float ltot = lrun + __shfl_xor(lrun, 32);
    const float rl = 1.0f / ltot;
    bf16_t* Y = (bf16_t*)(ws + WS_HB) + (size_t)type * T * AW + (rowbase + qpos) * AW + h * 64 + 4 * hi;
#pragma unroll
    for (int g = 0; g < 4; ++g) {
        *(u32x2*)(Y + 8 * g) = (u32x2){pk2(o0[4 * g] * rl, o0[4 * g + 1] * rl), pk2(o0[4 * g + 2] * rl, o0[4 * g + 3] * rl)};
        *(u32x2*)(Y + 32 + 8 * g) = (u32x2){pk2(o1[4 * g] * rl, o1[4 * g + 1] * rl), pk2(o1[4 * g + 2] * rl, o1[4 * g + 3] * rl)};
    }
}

__device__ __forceinline__ void p3_unit(const Ctx& C, const Args& a, int pm, int pn8) {
    unsigned char* ws = a.ws;
    int tid = C.tid; asm volatile("" : "+v"(tid)); const int lane = tid & 63, wr = C.wave >> 2, wc = C.wave & 3, fr = lane & 15, fq = lane >> 4;
    GSrc s0, s1;
    s0.abase = (const char*)(ws + WS_HB); s1.abase = (const char*)(ws + WS_HB) + (size_t)T * AW * 2;
    s0.bbase0 = (const char*)(ws + WS_WF) + (size_t)(pn8 * 128) * 1024; s0.bbase1 = s0.bbase0;
    s1.bbase1 = (const char*)(ws + WS_WM) + (size_t)(pn8 * 128) * 1024; s1.bbase0 = s1.bbase1;
#pragma unroll
    for (int i = 0; i < 4; ++i) { s0.aoff[i] = (unsigned)((pm * 256 + (tid >> 3) + 64 * i) * 1024 + (tid & 7) * 16); s1.aoff[i] = s0.aoff[i]; }
#pragma unroll
    for (int i = 0; i < 2; ++i) { s0.boff[i] = (unsigned)(((tid >> 3) + 64 * i) * 1024 + (tid & 7) * 16); s1.boff[i] = s0.boff[i]; }
    Acc acc; acc_zero(acc);
    gemm_split(C, acc, s0, 512, s1, 512);
    const bf16_t* SA = (const bf16_t*)(ws + WS_SA); const bf16_t* SB = (const bf16_t*)(ws + WS_SB); bf16_t* MX = (bf16_t*)(ws + WS_MIXED);
    const int cb = pn8 * 128 + 32 * wc + 4 * fq;
#pragma unroll
    for (int ai = 0; ai < 2; ++ai)
#pragma unroll
        for (int m = 0; m < 4; ++m) { const size_t ro = (size_t)(pm * 256 + 128 * ai + 64 * wr + 16 * m + fr) * DM + cb;
#pragma unroll
            for (int n = 0; n < 2; ++n) { const u32x2 ga = *(const u32x2*)(SA + ro + 16 * n), gb = *(const u32x2*)(SB + ro + 16 * n);
                const f32x4 ya = acc[ai][0][m][n], yb = acc[ai][1][m][n];
                const float r0 = bflo(ga.x) * ya.x + bflo(gb.x) * yb.x, r1 = bfhi(ga.x) * ya.y + bfhi(gb.x) * yb.y;
                const float r2 = bflo(ga.y) * ya.z + bflo(gb.y) * yb.z, r3 = bfhi(ga.y) * ya.w + bfhi(gb.y) * yb.w;
                *(u32x2*)(MX + ro + 16 * n) = (u32x2){pk2(r0, r1), pk2(r2, r3)}; } EPI_FENCE(); }
}
__device__ __forceinline__ void p4_unit(const Ctx& C, const Args& a, int pm, int pn) {
    unsigned char* ws = a.ws;
    int tid = C.tid; asm volatile("" : "+v"(tid)); const int lane = tid & 63, wr = C.wave >> 2, wc = C.wave & 3, fr = lane & 15, fq = lane >> 4;
    GSrc s; s.abase = (const char*)(ws + WS_MIXED); s.bbase0 = (const char*)(ws + WS_WO) + (size_t)(pn * 256) * 2048; s.bbase1 = s.bbase0 + (size_t)128 * 2048;
#pragma unroll
    for (int i = 0; i < 4; ++i) s.aoff[i] = (unsigned)((pm * 256 + (tid >> 3) + 64 * i) * 2048 + (tid & 7) * 16);
#pragma unroll
    for (int i = 0; i < 2; ++i) s.boff[i] = (unsigned)(((tid >> 3) + 64 * i) * 2048 + (tid & 7) * 16);
    Acc acc; acc_zero(acc);
    gemm_full(C, acc, s, 1024);
    bf16_t* XB = (bf16_t*)(ws + WS_HB);
    const int cb = pn * 256 + 32 * wc + 4 * fq;
#pragma unroll
    for (int ai = 0; ai < 2; ++ai)
#pragma unroll
        for (int m = 0; m < 4; ++m) { const size_t ro = (size_t)(pm * 256 + 128 * ai + 64 * wr + 16 * m + fr) * DM + cb;
#pragma unroll
            for (int bj = 0; bj < 2; ++bj)
#pragma unroll
                for (int n = 0; n < 2; ++n) { const f32x4 v = *(const f32x4*)(a.in[0] + ro + 128 * bj + 16 * n) + acc[ai][bj][m][n];
                    *(f32x4*)(a.out + ro + 128 * bj + 16 * n) = v; *(u32x2*)(XB + ro + 128 * bj + 16 * n) = (u32x2){pk2(v.x, v.y), pk2(v.z, v.w)}; } EPI_FENCE(); }
}

__device__ __forceinline__ void p5_task(const Ctx& C, const Args& a, int task) {
    unsigned char* ws = a.ws;
    const int lane = C.lane, w = C.wave, tg = w >> 2, kq = w & 3;
    const int tok0 = task * 128 + 64 * tg;
    LAS float* tile = (LAS float*)(C.lds + w * 9728);
    const float* X1 = a.out; const float* gn = a.in[8]; const float* WGp = a.in[9]; const float* WFp = a.in[11];
    float acc[36]; float ss = 0.f;
#pragma unroll
    for (int c = 0; c < 36; ++c) acc[c] = 0.f;
    for (int kc = 0; kc < 8; ++kc) {
        const int kb = kq * 256 + kc * 32;
#pragma unroll
        for (int i = 0; i < 8; ++i) { const int tr = i * 8 + (lane >> 3), k4 = (lane & 7) * 4; const f32x4 v = *(const f32x4*)(X1 + (size_t)(tok0 + tr) * DM + kb + k4);
            tile[tr * 33 + k4] = v.x; tile[tr * 33 + k4 + 1] = v.y; tile[tr * 33 + k4 + 2] = v.z; tile[tr * 33 + k4 + 3] = v.w; }
        asm volatile("s_waitcnt lgkmcnt(0)" ::: "memory");
        for (int k = 0; k < 32; ++k) {
            const int kk = __builtin_amdgcn_readfirstlane(kb + k);
            const float x = tile[lane * 33 + k]; ss += x * x;
            const float xg = x * gn[kk];
            const float* wg = WGp + (size_t)kk * 4; const float* wf = WFp + (size_t)kk * 32;
#pragma unroll
            for (int c = 0; c < 4; ++c) acc[c] += xg * wg[c];
#pragma unroll
            for (int c = 0; c < 32; ++c) acc[4 + c] += xg * wf[c];
        }
        asm volatile("s_waitcnt lgkmcnt(0)" ::: "memory");
    }
    __syncthreads();
    LAS float* comb = (LAS float*)(C.lds + w * 9728);
#pragma unroll
    for (int c = 0; c < 36; ++c) comb[lane * 37 + c] = acc[c];
    comb[lane * 37 + 36] = ss;
    __syncthreads();
    if (kq == 0) {
#pragma unroll
        for (int q = 1; q < 4; ++q) { LAS const float* cq = (LAS const float*)(C.lds + (w + q) * 9728);
#pragma unroll
            for (int c = 0; c < 36; ++c) acc[c] += cq[lane * 37 + c];
            ss += cq[lane * 37 + 36]; }
        const int tok = tok0 + lane;
        const float rstd = 1.0f / sqrtf(ss * (1.0f / DM) + RMS_EPS);
        ((float*)(ws + WS_RSTD2))[tok] = rstd;
        float lg[4];
#pragma unroll
        for (int c = 0; c < 4; ++c) lg[c] = acc[c] * rstd + a.in[10][c];
        int gi = 0; float gm = lg[0];
#pragma unroll
        for (int c = 1; c < 4; ++c) if (lg[c] > gm) { gm = lg[c]; gi = c; }
        float gs = 0.f;
#pragma unroll
        for (int c = 0; c < 4; ++c) gs += __expf(lg[c] - gm);
        const float gtop = 1.0f / gs;
        float lf[8];
#pragma unroll
        for (int j = 0; j < 8; ++j) { const float v0 = acc[4 + j], v1 = acc[12 + j], v2 = acc[20 + j], v3 = acc[28 + j];
            const float v = (gi == 0) ? v0 : (gi == 1) ? v1 : (gi == 2) ? v2 : v3; lf[j] = v * rstd + a.in[12][gi * 8 + j]; }
        int i1 = 0, i2 = 0; float f1 = -INFINITY, f2 = -INFINITY;
#pragma unroll
        for (int j = 0; j < 8; ++j) { if (lf[j] > f1) { f2 = f1; i2 = i1; f1 = lf[j]; i1 = j; } else if (lf[j] > f2) { f2 = lf[j]; i2 = j; } }
        const float e2 = __expf(f2 - f1), den = 1.0f / (1.0f + e2);
        float* TW = (float*)(ws + WS_TOKW);
        TW[tok * 2] = gtop * den; TW[tok * 2 + 1] = gtop * e2 * den;
        const int ea = gi * 8 + i1, eb = gi * 8 + i2;
        unsigned* CNT = (unsigned*)(ws + WS_CTL) + CW_CNT; int* LISTS = (int*)(ws + WS_LISTS);
        const unsigned long long ltm = (lane == 0) ? 0ull : (~0ull >> (64 - lane));
        for (int e = 0; e < NE; ++e) {
            const unsigned long long m1 = __ballot(ea == e), m2 = __ballot(eb == e);
            const int n1 = __popcll(m1), n2 = __popcll(m2);
            if (n1 + n2 == 0) continue;
            unsigned base = 0u;
            if (lane == 0) base = __hip_atomic_fetch_add(CNT + e, (unsigned)(n1 + n2), __ATOMIC_RELAXED, __HIP_MEMORY_SCOPE_AGENT);
            base = __builtin_amdgcn_readfirstlane(base);
            if (ea == e) LISTS[(size_t)e * T + base + __popcll(m1 & ltm)] = tok * 2;
            if (eb == e) LISTS[(size_t)e * T + base + n1 + __popcll(m2 & ltm)] = tok * 2 + 1;
        }
    }
    __syncthreads();
}

__device__ __forceinline__ int moe_tiles(const Ctx& C, const Args& a, LAS int* tst) {
    if (C.tid == 0) { const unsigned* CNT = (const unsigned*)(a.ws + WS_CTL) + CW_CNT; int run = 0;
        for (int e = 0; e < NE; ++e) { const int c = (int)__hip_atomic_load(CNT + e, __ATOMIC_RELAXED, __HIP_MEMORY_SCOPE_AGENT); tst[e] = run; tst[33 + e] = c; run += (c + 255) >> 8; }
        tst[32] = run; }
    __syncthreads();
    return tst[32];
}
__device__ __forceinline__ void p6_unit(const Ctx& C, const Args& a, int e, int rt, int gt, int cnt, int pn4) {
    unsigned char* ws = a.ws;
    int tid = C.tid; asm volatile("" : "+v"(tid)); const int lane = tid & 63, wr = C.wave >> 2, wc = C.wave & 3, fr = lane & 15, fq = lane >> 4;
    const int* LIST = (const int*)(ws + WS_LISTS) + (size_t)e * T + rt * 256; const int nvalid = cnt - rt * 256;
    GSrc s; s.abase = (const char*)(ws + WS_HB);
    s.bbase0 = (const char*)(ws + WS_WG) + ((size_t)e * DE + pn4 * 128) * 2048; s.bbase1 = (const char*)(ws + WS_WU) + ((size_t)e * DE + pn4 * 128) * 2048;
#pragma unroll
    for (int i = 0; i < 4; ++i) { const int r = (tid >> 3) + 64 * i; const int tok = (r < nvalid) ? (LIST[r] >> 1) : 0; s.aoff[i] = (unsigned)(tok * 2048 + (tid & 7) * 16); }
#pragma unroll
    for (int i = 0; i < 2; ++i) s.boff[i] = (unsigned)(((tid >> 3) + 64 * i) * 2048 + (tid & 7) * 16);
    Acc acc; acc_zero(acc);
    gemm_full(C, acc, s, 1024);
    const float* RS = (const float*)(ws + WS_RSTD2); bf16_t* HBUF = (bf16_t*)(ws + WS_HBUF);
    const int cb = pn4 * 128 + 32 * wc + 4 * fq;
#pragma unroll
    for (int ai = 0; ai < 2; ++ai)
#pragma unroll
        for (int m = 0; m < 4; ++m) { const int r = 128 * ai + 64 * wr + 16 * m + fr; const float rs = (r < nvalid) ? RS[LIST[r] >> 1] : 0.f;
            bf16_t* rp = HBUF + (size_t)(gt * 256 + r) * DE + cb;
#pragma unroll
            for (int n = 0; n < 2; ++n) { const f32x4 g = acc[ai][0][m][n] * rs, u = acc[ai][1][m][n] * rs;
                const float h0 = g.x * sigmoidf_(g.x) * u.x, h1 = g.y * sigmoidf_(g.y) * u.y, h2 = g.z * sigmoidf_(g.z) * u.z, h3 = g.w * sigmoidf_(g.w) * u.w;
                *(u32x2*)(rp + 16 * n) = (u32x2){pk2(h0, h1), pk2(h2, h3)}; } EPI_FENCE(); }
}
__device__ __forceinline__ void p7_unit(const Ctx& C, const Args& a, int e, int rt, int gt, int cnt, int pn) {
    unsigned char* ws = a.ws;
    int tid = C.tid; asm volatile("" : "+v"(tid)); const int lane = tid & 63, wr = C.wave >> 2, wc = C.wave & 3, fr = lane & 15, fq = lane >> 4;
    const int* LIST = (const int*)(ws + WS_LISTS) + (size_t)e * T + rt * 256; const int nvalid = cnt - rt * 256;
    GSrc s; s.abase = (const char*)(ws + WS_HBUF) + (size_t)gt * 256 * 1024;
    s.bbase0 = (const char*)(ws + WS_WD) + ((size_t)e * DM + pn * 256) * 1024; s.bbase1 = s.bbase0 + (size_t)128 * 1024;
#pragma unroll
    for (int i = 0; i < 4; ++i) s.aoff[i] = (unsigned)(((tid >> 3) + 64 * i) * 1024 + (tid & 7) * 16);
#pragma unroll
    for (int i = 0; i < 2; ++i) s.boff[i] = (unsigned)(((tid >> 3) + 64 * i) * 1024 + (tid & 7) * 16);
    Acc acc; acc_zero(acc);
    gemm_full(C, acc, s, 512);
    const float* TW = (const float*)(ws + WS_TOKW); bf16_t* CT = (bf16_t*)(ws + WS_CONTRIB);
    const int cb = pn * 256 + 32 * wc + 4 * fq;
#pragma unroll
    for (int ai = 0; ai < 2; ++ai)
#pragma unroll
        for (int m = 0; m < 4; ++m) { const int r = 128 * ai + 64 * wr + 16 * m + fr;
            if (r < nvalid) { const int ent = LIST[r]; const float wgt = TW[ent]; bf16_t* rp = CT + (size_t)ent * DM + cb;
#pragma unroll
                for (int bj = 0; bj < 2; ++bj)
#pragma unroll
                    for (int n = 0; n < 2; ++n) { const f32x4 v = acc[ai][bj][m][n] * wgt; *(u32x2*)(rp + 128 * bj + 16 * n) = (u32x2){pk2(v.x, v.y), pk2(v.z, v.w)}; } } EPI_FENCE(); }
}

__device__ __forceinline__ void phase8(const Ctx& C, const Args& a) {
    unsigned char* ws = a.ws;
    const int gw = C.vcu * 8 + C.wave, NGW = C.G * 8;
    const bf16_t* CT = (const bf16_t*)(ws + WS_CONTRIB); bf16_t* XB = (bf16_t*)(ws + WS_HB); bf16_t* PB = (bf16_t*)(ws + WS_PB); float* RS3 = (float*)(ws + WS_RSTD3);
    for (int t = gw; t < T; t += NGW) {
        f32x4* xr = (f32x4*)(a.out + (size_t)t * DM) + C.lane;
        const u32x2* c0 = (const u32x2*)(CT + (size_t)(2 * t) * DM) + C.lane; const u32x2* c1 = (const u32x2*)(CT + (size_t)(2 * t + 1) * DM) + C.lane;
        u32x2* xb = (u32x2*)(XB + (size_t)t * DM) + C.lane;
        float ss = 0.f;
#pragma unroll
        for (int j = 0; j < 4; ++j) { f32x4 v = xr[64 * j]; const u32x2 u0 = c0[64 * j], u1 = c1[64 * j];
            v.x = (v.x + bflo(u0.x)) + bflo(u1.x); v.y = (v.y + bfhi(u0.x)) + bfhi(u1.x); v.z = (v.z + bflo(u0.y)) + bflo(u1.y); v.w = (v.w + bfhi(u0.y)) + bfhi(u1.y);
            ss += (v.x * v.x + v.y * v.y) + (v.z * v.z + v.w * v.w);
            xr[64 * j] = v; xb[64 * j] = (u32x2){pk2(v.x, v.y), pk2(v.z, v.w)}; }
        ss = wave_sum(ss);
        if (C.lane == 0) RS3[t] = 1.0f / sqrtf(ss * (1.0f / DM) + RMS_EPS);
        const f32x4 pv = *((const f32x4*)(a.in[1] + (size_t)t * PLE) + C.lane);
        *((u32x2*)(PB + (size_t)t * PLE) + C.lane) = (u32x2){pk2(pv.x, pv.y), pk2(pv.z, pv.w)};
    }
}
__device__ __forceinline__ void p9_unit(const Ctx& C, const Args& a, int pm, int pn8) {
    unsigned char* ws = a.ws;
    int tid = C.tid; asm volatile("" : "+v"(tid)); const int lane = tid & 63, wr = C.wave >> 2, wc = C.wave & 3, fr = lane & 15, fq = lane >> 4;
    GSrc s0, s1;
    s0.abase = (const char*)(ws + WS_HB); s1.abase = (const char*)(ws + WS_PB);
    s0.bbase0 = (const char*)(ws + WS_WPG) + (size_t)(pn8 * 128) * 2048; s0.bbase1 = s0.bbase0;
    s1.bbase1 = (const char*)(ws + WS_WPP) + (size_t)(pn8 * 128) * 512; s1.bbase0 = s1.bbase1;
#pragma unroll
    for (int i = 0; i < 4; ++i) { s0.aoff[i] = (unsigned)((pm * 256 + (tid >> 3) + 64 * i) * 2048 + (tid & 7) * 16); s1.aoff[i] = (unsigned)((pm * 256 + (tid >> 3) + 64 * i) * 512 + (tid & 7) * 16); }
#pragma unroll
    for (int i = 0; i < 2; ++i) { s0.boff[i] = (unsigned)(((tid >> 3) + 64 * i) * 2048 + (tid & 7) * 16); s1.boff[i] = (unsigned)(((tid >> 3) + 64 * i) * 512 + (tid & 7) * 16); }
    Acc acc; acc_zero(acc);
    gemm_split(C, acc, s0, 1024, s1, 256);
    const float* RS3 = (const float*)(ws + WS_RSTD3);
    const int cb = pn8 * 128 + 32 * wc + 4 * fq;
#pragma unroll
    for (int ai = 0; ai < 2; ++ai)
#pragma unroll
        for (int m = 0; m < 4; ++m) { const int row = pm * 256 + 128 * ai + 64 * wr + 16 * m + fr; const float rs = RS3[row]; float* rp = a.out + (size_t)row * DM + cb;
#pragma unroll
            for (int n = 0; n < 2; ++n) { const f32x4 g = acc[ai][0][m][n] * rs, pp = acc[ai][1][m][n]; f32x4 v = *(const f32x4*)(rp + 16 * n);
                v.x += sigmoidf_(g.x) * pp.x; v.y += sigmoidf_(g.y) * pp.y; v.z += sigmoidf_(g.z) * pp.z; v.w += sigmoidf_(g.w) * pp.w;
                *(f32x4*)(rp + 16 * n) = v; } EPI_FENCE(); }
}
__device__ __forceinline__ void phase10(const Ctx& C, const Args& a) {
    const int gw = C.vcu * 8 + C.wave, NGW = C.G * 8;
    f32x4 gv[4];
#pragma unroll
    for (int j = 0; j < 4; ++j) gv[j] = *(const f32x4*)(a.in[19] + 4 * C.lane + 256 * j);
    for (int t = gw; t < T; t += NGW) {
        f32x4* xr = (f32x4*)(a.out + (size_t)t * DM) + C.lane;
        f32x4 v[4]; float ss = 0.f;
#pragma unroll
        for (int j = 0; j < 4; ++j) { v[j] = xr[64 * j]; ss += (v[j].x * v[j].x + v[j].y * v[j].y) + (v[j].z * v[j].z + v[j].w * v[j].w); }
        const float rstd = 1.0f / sqrtf(wave_sum(ss) * (1.0f / DM) + RMS_EPS);
#pragma unroll
        for (int j = 0; j < 4; ++j) xr[64 * j] = v[j] * rstd * gv[j];
    }
}

__global__ void __launch_bounds__(512, 2) fwd_kernel(Args args) {
    extern __shared__ __attribute__((aligned(16))) unsigned char lds_raw[];
    Ctx C;
    C.lds = (LAS unsigned char*)lds_raw;
    C.tid = threadIdx.x; C.lane = C.tid & 63; C.wave = __builtin_amdgcn_readfirstlane(C.tid >> 6);
    C.G = gridDim.x; { const int bx = blockIdx.x; C.vcu = (C.G % 8 == 0) ? (bx % 8) * (C.G / 8) + bx / 8 : bx; }
    volatile LAS unsigned* MISC = (volatile LAS unsigned*)(C.lds + MISC_OFF);
    LAS int* TST = (LAS int*)(C.lds + MISC_OFF + 256);
    for (int u = C.tid; u < (LDS_BYTES - MISC_OFF) / 4; u += 512) ((LAS unsigned*)(C.lds + MISC_OFF))[u] = 0u;
    __syncthreads();
    unsigned* ctl = (unsigned*)(args.ws + WS_CTL);
    XcdBarrier bar; bar.bar = ctl + CW_BAR; bar.x = 0; bar.st = nullptr;
    const int lo = args.ph_lo, hi = args.ph_hi;
    if (hi - lo > 1) bar = xcd_barrier_post(ctl + CW_BAR, MISC + 8);
#define IN(k) (lo <= (k) && (k) < hi)
#define SEAM(k) do { if (IN(k) && IN((k) + 1)) xcd_barrier(bar); } while (0)

    if (IN(0)) { phase0(C, args); } SEAM(0);
    if (IN(1)) {
        p1_cumsum(C, args);
        for (int u = C.vcu; u < 2560; u += C.G) { if (u < 2048) p1_unit_proj(C, args, u >> 4, u & 15); else p1_unit_vt(C, args, (u - 2048) & 3, (u - 2048) >> 2); }
    } SEAM(1);
    if (IN(2)) {
        for (;;) {
            if (C.tid == 0) MISC[16] = __hip_atomic_fetch_add(ctl + CW_ATTCTR, 1u, __ATOMIC_RELAXED, __HIP_MEMORY_SCOPE_AGENT);
            __syncthreads();
            const int u = (int)MISC[16];
            __syncthreads();
            if (u >= 2048) break;
            const int qb = 15 - (u >> 7), rest = u & 127;
            attn_unit(C, args, rest >> 6, rest & 63, qb);
        }
    } SEAM(2);
    if (IN(3)) { for (int u = C.vcu; u < 1024; u += C.G) p3_unit(C, args, u >> 3, u & 7); } SEAM(3);
    if (IN(4)) { for (int u = C.vcu; u < 512; u += C.G) p4_unit(C, args, u >> 2, u & 3); } SEAM(4);
    if (IN(5)) { for (int u = C.vcu; u < 256; u += C.G) p5_task(C, args, u); } SEAM(5);
    if (IN(6)) {
        const int ntile = moe_tiles(C, args, TST);
        for (int u = C.vcu; u < ntile * 4; u += C.G) { const int gt = u >> 2; int e = 0;
            for (int j = 1; j < NE; ++j) if (TST[j] <= gt) e = j;
            p6_unit(C, args, e, gt - TST[e], gt, TST[33 + e], u & 3); }
    } SEAM(6);
    if (IN(7)) {
        const int ntile = moe_tiles(C, args, TST);
        for (int u = C.vcu; u < ntile * 4; u += C.G) { const int gt = u >> 2; int e = 0;
            for (int j = 1; j < NE; ++j) if (TST[j] <= gt) e = j;
            p7_unit(C, args, e, gt - TST[e], gt, TST[33 + e], u & 3); }
    } SEAM(7);
    if (IN(8)) { phase8(C, args); } SEAM(8);
    if (IN(9)) { for (int u = C.vcu; u < 1024; u += C.G) p9_unit(C, args, u >> 3, u & 7); } SEAM(9);
    if (IN(10)) { phase10(C, args); }
#undef IN
#undef SEAM
}

extern "C" void kernel_launch(void* const* d_in, const int* in_sizes, int n_in, void* d_out, int out_size, void* d_ws, size_t ws_size, hipStream_t stream) {
    static int grid = 0;
    if (grid == 0) {
        if (n_in != 20 || in_sizes[0] != T * DM || out_size != T * DM || ws_size < WS_END) { fprintf(stderr, "kernel_launch: unexpected shapes (n_in %d, ws %zu)\n", n_in, ws_size); grid = -1; return; }
        int dev = 0, cus = 0, per_cu = 0;
        if (hipGetDevice(&dev) != hipSuccess || hipDeviceGetAttribute(&cus, hipDeviceAttributeMultiprocessorCount, dev) != hipSuccess) { grid = -1; return; }
        if (hipFuncSetAttribute((const void*)fwd_kernel, hipFuncAttributeMaxDynamicSharedMemorySize, LDS_BYTES) != hipSuccess) { fprintf(stderr, "kernel_launch: hipFuncSetAttribute failed\n"); grid = -1; return; }
        if (hipOccupancyMaxActiveBlocksPerMultiprocessor(&per_cu, (const void*)fwd_kernel, 512, LDS_BYTES) != hipSuccess || per_cu < 1) { fprintf(stderr, "kernel_launch: occupancy query says %d blocks/CU\n", per_cu); (void)hipGetLastError(); grid = -1; return; }
        grid = cus;
    }
    if (grid < 0) return;
    if (hipMemsetAsync((char*)d_ws + WS_CTL, 0, CTL_BYTES, stream) != hipSuccess) return;
    Args a{};
    for (int i = 0; i < 20; ++i) a.in[i] = (const float*)d_in[i];
    a.out = (float*)d_out; a.ws = (unsigned char*)d_ws;
    if (MK_N_LAUNCHES == 1) {
        a.ph_lo = 0; a.ph_hi = NPH;
        hipLaunchKernelGGL(fwd_kernel, dim3(grid), dim3(512), LDS_BYTES, stream, a);
    } else {
        for (int p = 0; p < NPH; ++p) { a.ph_lo = p; a.ph_hi = p + 1; hipLaunchKernelGGL(fwd_kernel, dim3(grid), dim3(512), LDS_BYTES, stream, a); }
    }
}
```

```cpp
#include <hip/hip_runtime.h>
#include <cstdio>
#include <cstdint>

#ifndef MK_N_LAUNCHES
#define MK_N_LAUNCHES 1
#endif

#define LAS __attribute__((address_space(3)))
typedef unsigned short bf16_t;
typedef short bf16x8 __attribute__((ext_vector_type(8)));
typedef short s16x4 __attribute__((ext_vector_type(4)));
typedef float f32x2 __attribute__((ext_vector_type(2)));
typedef float f32x4 __attribute__((ext_vector_type(4)));
typedef float f32x16 __attribute__((ext_vector_type(16)));
typedef unsigned u32x2 __attribute__((ext_vector_type(2)));
typedef unsigned u32x4 __attribute__((ext_vector_type(4)));
typedef __bf16 bf16x2_t __attribute__((ext_vector_type(2)));

constexpr int NB = 8, SEQ = 4096, T = NB * SEQ, DM = 1024, NH = 8, HD = 64, AW = 512, PLE = 256, NE = 32, DE = 512, INC = 5128;
constexpr int NPH = 11;
constexpr float RMS_EPS = 1e-6f;
constexpr float LOG2E = 1.4426950408889634f;
constexpr float QSCALE = 0.125f * LOG2E;

constexpr size_t MiB_ = 1u << 20;
constexpr size_t XS_SEL = 0;
constexpr size_t XS_LIST = 2 * MiB_;
constexpr size_t XS_ML = 10 * MiB_;
constexpr size_t XS_PART = 16 * MiB_;
constexpr int LIST_CAP = 3840, GCHUNK = 1024;
constexpr size_t MiB = 1u << 20;
constexpr size_t WS_CTL = 0, CTL_BYTES = 1 * MiB;
constexpr size_t WS_W1 = 1 * MiB;
constexpr size_t WS_WV = 9 * MiB;
constexpr size_t WS_WF = 11 * MiB;
constexpr size_t WS_WM = 12 * MiB;
constexpr size_t WS_WO = 13 * MiB;
constexpr size_t WS_WPG = 15 * MiB;
constexpr size_t WS_WPP = 17 * MiB;
constexpr size_t WS_WG = 18 * MiB;
constexpr size_t WS_WU = 50 * MiB;
constexpr size_t WS_WD = 82 * MiB;
constexpr size_t WS_COS = 114 * MiB;
constexpr size_t WS_SIN = WS_COS + 512 * 1024;
constexpr size_t WS_LOGF = 115 * MiB;
constexpr size_t WS_C2 = 116 * MiB;
constexpr size_t WS_KMP = 117 * MiB;
constexpr size_t WS_RSTD2 = 118 * MiB;
constexpr size_t WS_RSTD3 = WS_RSTD2 + 128 * 1024;
constexpr size_t WS_TOKW = WS_RSTD3 + 128 * 1024;
constexpr size_t WS_LISTS = 119 * MiB;
constexpr size_t WS_WRH = 124 * MiB;
constexpr size_t WS_WRL = WS_WRH + 98304;
constexpr size_t WS_XSLOT = 125 * MiB;
constexpr size_t WS_HB = 128 * MiB;
constexpr size_t WS_QF = 192 * MiB, WS_KF = 224 * MiB, WS_QM = 256 * MiB, WS_KM = 288 * MiB;
constexpr size_t WS_CONTRIB = 128 * MiB;
constexpr size_t WS_X1 = 256 * MiB;
constexpr size_t WS_VT = 320 * MiB;
constexpr size_t WS_MIXED = 320 * MiB, WS_PB = 320 * MiB;
constexpr size_t WS_SA = 384 * MiB, WS_SB = 448 * MiB;
constexpr size_t WS_HBUF = 384 * MiB;
constexpr size_t WS_END = 512 * MiB;

constexpr int CW_ATTCTR = 8;
constexpr int CW_CNT = 8192;
constexpr int CW_KMAX = 16384;
constexpr int CW_BAR = 4096;
constexpr int CW_XCNT = 32768;
constexpr int CW_XTMO = 2;
constexpr int CW_LCNT = 196608;
constexpr int CW_SELDONE = 12;
constexpr int CW_GDONE = 229376;
constexpr int CW_P34 = 131072;
constexpr int CW_P45 = 163840;
constexpr int CW_MOE = 65536;

constexpr int LDS_BYTES = 147456;
constexpr int MISC_OFF = 131072;

__device__ __forceinline__ unsigned pk2(float lo, float hi) { f32x2 v = {lo, hi}; bf16x2_t b = __builtin_convertvector(v, bf16x2_t); return __builtin_bit_cast(unsigned, b); }
__device__ __forceinline__ float bflo(unsigned u) { return __builtin_bit_cast(float, u << 16); }
__device__ __forceinline__ float bfhi(unsigned u) { return __builtin_bit_cast(float, u & 0xffff0000u); }
__device__ __forceinline__ float xhalf_max(float x) { const auto r = __builtin_amdgcn_permlane32_swap(__float_as_uint(x), __float_as_uint(x), false, false); return __builtin_fmaxf(__uint_as_float(r[0]), __uint_as_float(r[1])); }
__device__ __forceinline__ float xhalf_sum(float x) { const auto r = __builtin_amdgcn_permlane32_swap(__float_as_uint(x), __float_as_uint(x), false, false); return __uint_as_float(r[0]) + __uint_as_float(r[1]); }
__device__ __forceinline__ float xhalf_lo(float x) { const auto r = __builtin_amdgcn_permlane32_swap(__float_as_uint(x), __float_as_uint(x), false, false); return __uint_as_float(r[0]); }
__device__ __forceinline__ float bf2f(short s) { return __builtin_bit_cast(float, ((unsigned)(unsigned short)s) << 16); }
__device__ __forceinline__ float wave_sum(float v) {
#pragma unroll
    for (int o = 1; o < 64; o <<= 1) v += __shfl_xor(v, o);
    return v;
}
__device__ __forceinline__ float sigmoidf_(float x) { return __builtin_amdgcn_rcpf(1.0f + __builtin_amdgcn_exp2f(x * -1.4426950408889634f)); }

__device__ __forceinline__ float sigmoid2_(float x2) { return __builtin_amdgcn_rcpf(1.0f + __builtin_amdgcn_exp2f(x2)); }
#define EPI_FENCE() asm volatile("" ::: "memory")
#define RL(m, fr) (32 * ((m) >> 1) + 8 * ((fr) >> 2) + 4 * ((m) & 1) + ((fr) & 3))
#define XB_TMO      128
#define XB_XCNT(j)  (256  + 64 * (j))
#define XB_XSUB(j)  (1280 + 64 * (j))
#define XB_XGEN(j)  (2304 + 64 * (j))
#define XB_TOP      3328
#define XB_TOPGEN   3392
#define XCD_BAR_WORDS 3456
#define XB_SPIN_CAP (1u << 22)
__device__ __forceinline__ unsigned xb_ld(unsigned* p)              { return __hip_atomic_load(p, __ATOMIC_RELAXED, __HIP_MEMORY_SCOPE_AGENT); }
__device__ __forceinline__ unsigned xb_add(unsigned* p, unsigned v) { return __hip_atomic_fetch_add(p, v, __ATOMIC_RELAXED, __HIP_MEMORY_SCOPE_AGENT); }
__device__ __forceinline__ unsigned xb_xcc_id() { return (unsigned)__builtin_amdgcn_s_getreg((3 << 11) | 20) & 0xFu; }
#define XB_SPIN(cond, bar) do { unsigned _sp = 0; while (cond) { __builtin_amdgcn_s_sleep(1); \
    if ((++_sp & 255u) == 0u) { if (xb_ld(&(bar)[XB_TMO])) break; if (_sp > XB_SPIN_CAP) { atomicAdd(&(bar)[XB_TMO], 1u); break; } } } } while (0)
__device__ __forceinline__ int lane_id_() { int l; asm volatile("v_mbcnt_lo_u32_b32 %0, -1, 0\n\tv_mbcnt_hi_u32_b32 %0, -1, %0" : "=v"(l)); return l; }
struct XcdBarrier { unsigned* bar; unsigned x; volatile LAS unsigned* st; int wave; };
__device__ __forceinline__ XcdBarrier xcd_barrier_post(unsigned* bar, volatile LAS unsigned* st, const int wave) {
    XcdBarrier b; b.bar = bar; b.x = xb_xcc_id(); b.st = st; b.wave = wave;
    if (wave == 0 && lane_id_() == 0) (void)xb_add(&bar[XB_XCNT(b.x)], 1u);
    return b;
}
__device__ __forceinline__ void xcd_barrier_complete(unsigned* bar, unsigned x, unsigned& nloc, unsigned& nx) {
    const unsigned G = gridDim.x * gridDim.y * gridDim.z;
    unsigned sum, cnt, mine, sp = 0u;
    for (;;) {
        sum = 0u; cnt = 0u; mine = 0u;
#pragma unroll
        for (unsigned j = 0; j < 16; ++j) { const unsigned c = xb_ld(&bar[XB_XCNT(j)]); sum += c; cnt += (c > 0u) ? 1u : 0u; mine = (j == x) ? c : mine; }
        if (sum == G) break;
        __builtin_amdgcn_s_sleep(1);
        if ((++sp & 255u) == 0u) { if (xb_ld(&bar[XB_TMO])) break; if (sp > XB_SPIN_CAP) { atomicAdd(&bar[XB_TMO], 1u); break; } }
    }
    nloc = mine > 0u ? mine : 1u; nx = cnt > 0u ? cnt : 1u;
}
__device__ __forceinline__ void xcd_barrier(const XcdBarrier& b) {
    asm volatile("s_waitcnt vmcnt(0)" ::: "memory");
    __syncthreads();
    if (b.wave == 0 && lane_id_() == 0) {
        unsigned* bar = b.bar;
        __builtin_amdgcn_s_waitcnt(0);
        unsigned nloc = b.st[0], nx = b.st[1];
        if (nloc == 0u) { xcd_barrier_complete(bar, b.x, nloc, nx); b.st[0] = nloc; b.st[1] = nx; }
        const unsigned old = xb_add(&bar[XB_XSUB(b.x)], 1u);
        const unsigned gen = old / nloc;
        if (old + 1u == (gen + 1u) * nloc) {
            __builtin_amdgcn_fence(__ATOMIC_RELEASE, "agent");
            asm volatile("s_waitcnt vmcnt(0)" ::: "memory");
            const unsigned og = xb_add(&bar[XB_TOP], 1u);
            const unsigned tg = og / nx;
            if (og + 1u == (tg + 1u) * nx) xb_add(&bar[XB_TOPGEN], 1u);
            else XB_SPIN(xb_ld(&bar[XB_TOPGEN]) == tg, bar);
            __builtin_amdgcn_fence(__ATOMIC_ACQUIRE, "agent");
            xb_add(&bar[XB_XGEN(b.x)], 1u);
            asm volatile("s_waitcnt vmcnt(0)" ::: "memory");
        } else {
            XB_SPIN(xb_ld(&bar[XB_XGEN(b.x)]) == gen, bar);
            __builtin_amdgcn_fence(__ATOMIC_ACQUIRE, "agent");
            asm volatile("s_waitcnt vmcnt(0)" ::: "memory");
        }
    }
    __syncthreads();
}

struct Args {
    const float* in[20];
    float* out;
    unsigned char* ws;
    int ph_lo, ph_hi;
};

struct Ctx {
    LAS unsigned char* lds;
    int wave, vcu, G;
};
__device__ __forceinline__ int opaque_tid(const int wave) { int t = (wave << 6) | lane_id_(); asm volatile("" : "+v"(t)); return t; }
__device__ __forceinline__ int opaque_tid(const Ctx& C) { return opaque_tid(C.wave); }


typedef f32x4 Acc[2][2][4][2];

__device__ __forceinline__ void acc_zero(Acc& acc) {
#pragma unroll
    for (int a = 0; a < 2; ++a)
#pragma unroll
        for (int b = 0; b < 2; ++b)
#pragma unroll
            for (int m = 0; m < 4; ++m)
#pragma unroll
                for (int n = 0; n < 2; ++n) acc[a][b][m][n] = (f32x4){0.f, 0.f, 0.f, 0.f};
}


namespace pg8 {
constexpr int BK = 64, HALF = 128, HTB = HALF * BK * 2;
__device__ __forceinline__ int lds_byte(int r, int c) { const int st = (r >> 4) * 2 + (c >> 5), rr = r & 15, cc = c & 31, ob = rr * 64 + cc * 2; return st * 1024 + (ob ^ (((ob >> 9) & 1) << 5)); }
__device__ __forceinline__ int perm32(int rho) { const int n = rho >> 4, i = rho & 15; return 8 * (i >> 2) + 4 * n + (i & 3); }
__device__ __forceinline__ void stage_rc(int b, int& R, int& Cc) { const int st = b / 1024, sb = b % 1024, swz = sb ^ (((sb >> 9) & 1) << 5); R = (st >> 1) * 16 + swz / 64; Cc = (st & 1) * 32 + (swz % 64) / 2; }
struct GUnit { const char* a0; const char* a1; const char* b0; const char* b1; int x0, x1, x2, x3; };

template <bool GATHER, class Sched, class Epi>
__device__ __forceinline__ void gemm_phase(LAS unsigned char* lds, const int wave_, const int K, const Sched& S, const Epi& E) {
    int tid = (wave_ << 6) | lane_id_(); asm volatile("" : "+v"(tid));
    const int wid = __builtin_amdgcn_readfirstlane(tid >> 6), lane = tid & 63, wr = wid >> 2, wc = wid & 3, fr = lane & 15, fq = lane >> 4;
    const int nt = K / BK;
    unsigned voff[2]; int RR[2], CC[2];
#pragma unroll
    for (int i = 0; i < 2; ++i) { stage_rc(tid * 16 + i * 8192, RR[i], CC[i]); RR[i] = (RR[i] & ~31) + perm32(RR[i] & 31); voff[i] = (unsigned)(RR[i] * K + CC[i]) * 2u; }
    const size_t kstep = (size_t)(BK * 2);
    const unsigned ldsw = (unsigned)wid * 1024u;
    const int aoff = lds_byte(wr * 64 + fr, fq * 8), boff = lds_byte(wc * 32 + fr, fq * 8);
#define PG8_SA(b, h) (((b) * 2 + (h)) * pg8::HTB)
#define PG8_SB(b, h) ((4 + (b) * 2 + (h)) * pg8::HTB)
#define PG8_STG(bufoff, gbase, o0, o1) do { \
        __builtin_amdgcn_global_load_lds((const unsigned*)((const char*)(gbase) + (o0)), (LAS unsigned*)(lds + (bufoff) + ldsw), 16, 0, 0); \
        __builtin_amdgcn_global_load_lds((const unsigned*)((const char*)(gbase) + (o1)), (LAS unsigned*)(lds + (bufoff) + ldsw + 8192), 16, 0, 0); } while (0)
#define PG8_LDA(dst, b, h) do { _Pragma("unroll") for (int m = 0; m < 4; ++m) _Pragma("unroll") for (int k = 0; k < 2; ++k) dst[m][k] = *(const LAS bf16x8*)(lds + PG8_SA(b, h) + aoff + m * 2048 + k * 1024); } while (0)
#define PG8_LDB(dst, b, h) do { _Pragma("unroll") for (int n = 0; n < 2; ++n) _Pragma("unroll") for (int k = 0; k < 2; ++k) dst[n][k] = *(const LAS bf16x8*)(lds + PG8_SB(b, h) + boff + n * 2048 + k * 1024); } while (0)
#define PG8_MMA(ai, bj, At, Bt) do { __builtin_amdgcn_s_setprio(1); _Pragma("unroll") for (int m = 0; m < 4; ++m) _Pragma("unroll") for (int n = 0; n < 2; ++n) _Pragma("unroll") for (int k = 0; k < 2; ++k) \
        acc[ai][bj][m][n] = __builtin_amdgcn_mfma_f32_16x16x32_bf16(Bt[n][k], At[m][k], acc[ai][bj][m][n], 0, 0, 0); __builtin_amdgcn_s_setprio(0); } while (0)
#define PG8_WAIT_V(n) asm volatile("s_waitcnt vmcnt(" #n ")" ::: "memory")
#define PG8_WAIT_L(n) asm volatile("s_waitcnt lgkmcnt(" #n ")" ::: "memory")
#define PG8_BAR __builtin_amdgcn_s_barrier()
#define PG8_SCHED __builtin_amdgcn_sched_barrier(0)
    GUnit cur, nxt; int ui = 0;
    if (!S.next(0, cur)) return;
    Acc acc; acc_zero(acc);
    bf16x8 At[4][2], B0[2][2], B1[2][2];
    unsigned vA0[2] = {voff[0], voff[1]}, vA1[2] = {voff[0], voff[1]}, nA0[2] = {voff[0], voff[1]}, nA1[2] = {voff[0], voff[1]};
    if constexpr (GATHER) S.avoff(cur, RR, CC, vA0, vA1);
    PG8_STG(PG8_SB(0, 0), cur.b0, voff[0], voff[1]); PG8_STG(PG8_SB(0, 1), cur.b1, voff[0], voff[1]); PG8_STG(PG8_SA(0, 0), cur.a0, vA0[0], vA0[1]); PG8_STG(PG8_SA(0, 1), cur.a1, vA1[0], vA1[1]);
    if (wr == 1) PG8_BAR;
    PG8_WAIT_V(2); PG8_BAR;
    PG8_STG(PG8_SB(1, 0), cur.b0 + kstep, voff[0], voff[1]); PG8_STG(PG8_SA(1, 0), cur.a0 + kstep, vA0[0], vA0[1]); PG8_STG(PG8_SB(1, 1), cur.b1 + kstep, voff[0], voff[1]);
    PG8_WAIT_V(6); PG8_BAR;
    for (;;) {
        const bool has_next = S.next(ui + 1, nxt);
        if (!has_next) nxt = cur;
        if constexpr (GATHER) { if (has_next) S.avoff(nxt, RR, CC, nA0, nA1); else { nA0[0] = vA0[0]; nA0[1] = vA0[1]; nA1[0] = vA1[0]; nA1[1] = vA1[1]; } }
        for (int t = 0; t < nt; t += 2) {
            const bool last = (t == nt - 2);
            const char* a1h1 = cur.a1 + (size_t)(t + 1) * kstep;
            const char* a2h0 = last ? nxt.a0 : cur.a0 + (size_t)(t + 2) * kstep; const char* a2h1 = last ? nxt.a1 : cur.a1 + (size_t)(t + 2) * kstep;
            const char* b2h0 = last ? nxt.b0 : cur.b0 + (size_t)(t + 2) * kstep; const char* b2h1 = last ? nxt.b1 : cur.b1 + (size_t)(t + 2) * kstep;
            const char* a3h0 = a2h0 + kstep; const char* b3h0 = b2h0 + kstep; const char* b3h1 = b2h1 + kstep;
            unsigned w0[2], w1[2];
            if (GATHER) { w0[0] = last ? nA0[0] : vA0[0]; w0[1] = last ? nA0[1] : vA0[1]; w1[0] = last ? nA1[0] : vA1[0]; w1[1] = last ? nA1[1] : vA1[1]; }
            else { w0[0] = voff[0]; w0[1] = voff[1]; w1[0] = voff[0]; w1[1] = voff[1]; }
            PG8_LDB(B0, 0, 0); PG8_LDB(B1, 0, 1); PG8_SCHED; PG8_LDA(At, 0, 0); PG8_STG(PG8_SA(1, 1), a1h1, vA1[0], vA1[1]);
            PG8_WAIT_V(8); PG8_WAIT_L(0); PG8_BAR; PG8_MMA(0, 0, At, B0); PG8_MMA(0, 1, At, B1); PG8_BAR; PG8_SCHED;
            PG8_LDA(At, 0, 1); PG8_STG(PG8_SB(0, 0), b2h0, voff[0], voff[1]); PG8_STG(PG8_SB(0, 1), b2h1, voff[0], voff[1]); PG8_STG(PG8_SA(0, 0), a2h0, w0[0], w0[1]);
            PG8_WAIT_V(8); PG8_WAIT_L(0); PG8_BAR; PG8_MMA(1, 0, At, B0); PG8_MMA(1, 1, At, B1); PG8_BAR; PG8_SCHED;
            PG8_LDB(B0, 1, 0); PG8_LDB(B1, 1, 1); PG8_SCHED; PG8_LDA(At, 1, 0); PG8_STG(PG8_SA(0, 1), a2h1, w1[0], w1[1]);
            PG8_WAIT_V(8); PG8_WAIT_L(0); PG8_BAR; PG8_MMA(0, 0, At, B0); PG8_MMA(0, 1, At, B1); PG8_BAR; PG8_SCHED;
            PG8_LDA(At, 1, 1); PG8_STG(PG8_SB(1, 0), b3h0, voff[0], voff[1]); PG8_STG(PG8_SB(1, 1), b3h1, voff[0], voff[1]); PG8_STG(PG8_SA(1, 0), a3h0, w0[0], w0[1]);
            PG8_WAIT_V(8); PG8_WAIT_L(0); PG8_BAR; PG8_MMA(1, 0, At, B0); PG8_MMA(1, 1, At, B1); PG8_BAR; PG8_SCHED;
        }
        if (wr == 0) PG8_BAR;
        E(acc, cur, wr, wc, fr, fq);
        if (!has_next) break;
        acc_zero(acc);
        cur = nxt; ++ui;
        if (GATHER) { vA0[0] = nA0[0]; vA0[1] = nA0[1]; vA1[0] = nA1[0]; vA1[1] = nA1[1]; }
        if (wr == 1) PG8_BAR;
    }
    PG8_WAIT_V(0);
    PG8_BAR;
#undef PG8_SA
#undef PG8_SB
#undef PG8_STG
#undef PG8_LDA
#undef PG8_LDB
#undef PG8_MMA
#undef PG8_WAIT_V
#undef PG8_WAIT_L
#undef PG8_BAR
#undef PG8_SCHED
}
}


namespace pg8 {
struct SUnit { const char* a0; const char* a1; const char* b0; const char* b1; int x0, x1, x2, x3, flags; };
constexpr int SF_PITCH1 = 1, SF_CHAIN = 2, SF_GATHER = 4, SF_WAIT = 8, SF_PUBLISH = 16;

template <class Sched, class Epi>
__device__ __forceinline__ void gemm_stream(LAS unsigned char* lds, const int wave_, const int pitch0, const int pitch1, const Sched& S, const Epi& E) {
    int tid = (wave_ << 6) | lane_id_(); asm volatile("" : "+v"(tid));
    const int wid = __builtin_amdgcn_readfirstlane(tid >> 6), lane = tid & 63, wr = wid >> 2, wc = wid & 3, fr = lane & 15, fq = lane >> 4;
    constexpr int nt = 8;
    int RR[2], CC[2];
#pragma unroll
    for (int i = 0; i < 2; ++i) { stage_rc(tid * 16 + i * 8192, RR[i], CC[i]); RR[i] = (RR[i] & ~31) + perm32(RR[i] & 31); }
    const size_t kstep = (size_t)(BK * 2);
    const unsigned ldsw = (unsigned)wid * 1024u;
    const int aoff = lds_byte(wr * 64 + fr, fq * 8), boff = lds_byte(wc * 32 + fr, fq * 8);
#define PG8_SA(b, h) (((b) * 2 + (h)) * pg8::HTB)
#define PG8_SB(b, h) ((4 + (b) * 2 + (h)) * pg8::HTB)
#define PG8_STG(bufoff, gbase, o0, o1) do { \
        __builtin_amdgcn_global_load_lds((const unsigned*)((const char*)(gbase) + (o0)), (LAS unsigned*)(lds + (bufoff) + ldsw), 16, 0, 0); \
        __builtin_amdgcn_global_load_lds((const unsigned*)((const char*)(gbase) + (o1)), (LAS unsigned*)(lds + (bufoff) + ldsw + 8192), 16, 0, 0); } while (0)
#define PG8_LDA(dst, b, h) do { _Pragma("unroll") for (int m = 0; m < 4; ++m) _Pragma("unroll") for (int k = 0; k < 2; ++k) dst[m][k] = *(const LAS bf16x8*)(lds + PG8_SA(b, h) + aoff + m * 2048 + k * 1024); } while (0)
#define PG8_LDB(dst, b, h) do { _Pragma("unroll") for (int n = 0; n < 2; ++n) _Pragma("unroll") for (int k = 0; k < 2; ++k) dst[n][k] = *(const LAS bf16x8*)(lds + PG8_SB(b, h) + boff + n * 2048 + k * 1024); } while (0)
#define PG8_MMA(ai, bj, At, Bt) do { __builtin_amdgcn_s_setprio(1); _Pragma("unroll") for (int m = 0; m < 4; ++m) _Pragma("unroll") for (int n = 0; n < 2; ++n) _Pragma("unroll") for (int k = 0; k < 2; ++k) \
        acc[ai][bj][m][n] = __builtin_amdgcn_mfma_f32_16x16x32_bf16(Bt[n][k], At[m][k], acc[ai][bj][m][n], 0, 0, 0); __builtin_amdgcn_s_setprio(0); } while (0)
#define PG8_WAIT_V(n) asm volatile("s_waitcnt vmcnt(" #n ")" ::: "memory")
#define PG8_WAIT_L(n) asm volatile("s_waitcnt lgkmcnt(" #n ")" ::: "memory")
#define PG8_BAR __builtin_amdgcn_s_barrier()
#define PG8_SCHED __builtin_amdgcn_sched_barrier(0)
#define PG8_OFFS(u, vB, vA0_, vA1_) do { const int pit_ = ((u).flags & SF_PITCH1) ? pitch1 : pitch0; vB[0] = (unsigned)(RR[0] * pit_ + CC[0]) * 2u; vB[1] = (unsigned)(RR[1] * pit_ + CC[1]) * 2u; \
        if ((u).flags & SF_GATHER) S.avoff((u), RR, CC, vA0_, vA1_); else { vA0_[0] = vB[0]; vA0_[1] = vB[1]; vA1_[0] = vB[0]; vA1_[1] = vB[1]; } } while (0)
    SUnit cur, nxt; int ui = 0;
    if (!S.next(0, cur)) return;
    Acc acc; acc_zero(acc);
    bf16x8 At[4][2], B0[2][2], B1[2][2];
    unsigned vB[2], vA0[2], vA1[2], nB[2], nA0[2], nA1[2];
    PG8_OFFS(cur, vB, vA0, vA1);
    S.a_ready(cur, wid);
    PG8_STG(PG8_SB(0, 0), cur.b0, vB[0], vB[1]); PG8_STG(PG8_SB(0, 1), cur.b1, vB[0], vB[1]); PG8_STG(PG8_SA(0, 0), cur.a0, vA0[0], vA0[1]); PG8_STG(PG8_SA(0, 1), cur.a1, vA1[0], vA1[1]);
    if (wr == 1) PG8_BAR;
    PG8_WAIT_V(2); PG8_BAR;
    PG8_STG(PG8_SB(1, 0), cur.b0 + kstep, vB[0], vB[1]); PG8_STG(PG8_SA(1, 0), cur.a0 + kstep, vA0[0], vA0[1]); PG8_STG(PG8_SB(1, 1), cur.b1 + kstep, vB[0], vB[1]);
    PG8_WAIT_V(6); PG8_BAR;
    for (;;) {
        const bool has_next = S.next(ui + 1, nxt);
        if (!has_next) { nxt = cur; nxt.flags &= ~(SF_WAIT); }
        PG8_OFFS(nxt, nB, nA0, nA1);
        for (int t = 0; t < nt; t += 2) {
            const bool last = (t == nt - 2);
            if (last && has_next) S.a_ready(nxt, wid);
            const char* a1h1 = cur.a1 + (size_t)(t + 1) * kstep;
            const char* a2h0 = last ? nxt.a0 : cur.a0 + (size_t)(t + 2) * kstep; const char* a2h1 = last ? nxt.a1 : cur.a1 + (size_t)(t + 2) * kstep;
            const char* b2h0 = last ? nxt.b0 : cur.b0 + (size_t)(t + 2) * kstep; const char* b2h1 = last ? nxt.b1 : cur.b1 + (size_t)(t + 2) * kstep;
            const char* a3h0 = a2h0 + kstep; const char* b3h0 = b2h0 + kstep; const char* b3h1 = b2h1 + kstep;
            unsigned w0[2], w1[2], wb[2];
            w0[0] = last ? nA0[0] : vA0[0]; w0[1] = last ? nA0[1] : vA0[1]; w1[0] = last ? nA1[0] : vA1[0]; w1[1] = last ? nA1[1] : vA1[1]; wb[0] = last ? nB[0] : vB[0]; wb[1] = last ? nB[1] : vB[1];
            PG8_LDB(B0, 0, 0); PG8_LDB(B1, 0, 1); PG8_SCHED; PG8_LDA(At, 0, 0); PG8_STG(PG8_SA(1, 1), a1h1, vA1[0], vA1[1]);
            PG8_WAIT_V(8); PG8_WAIT_L(0); PG8_BAR; PG8_MMA(0, 0, At, B0); PG8_MMA(0, 1, At, B1); PG8_BAR; PG8_SCHED;
            PG8_LDA(At, 0, 1); PG8_STG(PG8_SB(0, 0), b2h0, wb[0], wb[1]); PG8_STG(PG8_SB(0, 1), b2h1, wb[0], wb[1]); PG8_STG(PG8_SA(0, 0), a2h0, w0[0], w0[1]);
            PG8_WAIT_V(8); PG8_WAIT_L(0); PG8_BAR; PG8_MMA(1, 0, At, B0); PG8_MMA(1, 1, At, B1); PG8_BAR; PG8_SCHED;
            PG8_LDB(B0, 1, 0); PG8_LDB(B1, 1, 1); PG8_SCHED; PG8_LDA(At, 1, 0); PG8_STG(PG8_SA(0, 1), a2h1, w1[0], w1[1]);
            PG8_WAIT_V(8); PG8_WAIT_L(0); PG8_BAR; PG8_MMA(0, 0, At, B0); PG8_MMA(0, 1, At, B1); PG8_BAR; PG8_SCHED;
            PG8_LDA(At, 1, 1); PG8_STG(PG8_SB(1, 0), b3h0, wb[0], wb[1]); PG8_STG(PG8_SB(1, 1), b3h1, wb[0], wb[1]); PG8_STG(PG8_SA(1, 0), a3h0, w0[0], w0[1]);
            PG8_WAIT_V(8); PG8_WAIT_L(0); PG8_BAR; PG8_MMA(1, 0, At, B0); PG8_MMA(1, 1, At, B1); PG8_BAR; PG8_SCHED;
        }
        if (!(cur.flags & SF_CHAIN)) {
            if (wr == 0) PG8_BAR;
            E(acc, cur, wr, wc, fr, fq);
            S.done(cur, lane);
            if (has_next) { acc_zero(acc); if (wr == 1) PG8_BAR; }
        }
        if (!has_next) break;
        cur = nxt; ++ui;
        vB[0] = nB[0]; vB[1] = nB[1]; vA0[0] = nA0[0]; vA0[1] = nA0[1]; vA1[0] = nA1[0]; vA1[1] = nA1[1];
    }
    PG8_WAIT_V(0);
    PG8_BAR;
#undef PG8_OFFS
#undef PG8_SA
#undef PG8_SB
#undef PG8_STG
#undef PG8_LDA
#undef PG8_LDB
#undef PG8_MMA
#undef PG8_WAIT_V
#undef PG8_WAIT_L
#undef PG8_BAR
#undef PG8_SCHED
}
}

template <int STAGE>
__device__ __forceinline__ void p0_item(f32x4 (&v)[16], const float* W, int ldw, int s0, int s1, int k0, bf16_t* dst, int v0, int dpitch, const float* gain, LAS float* scr, int lane, const float cs = 1.0f) {
    const int c4 = lane & 15, rq = lane >> 4;
    if (STAGE == 0) {
        const int scol = ((c4 < 8) ? s0 : s1) + (c4 & 7) * 4;
#pragma unroll
        for (int i = 0; i < 16; ++i) v[i] = *(const f32x4*)(W + (size_t)(k0 + 4 * i + rq) * ldw + scol);
        return;
    }
    if (gain) {
#pragma unroll
        for (int i = 0; i < 16; ++i) v[i] = v[i] * gain[k0 + 4 * i + rq];
    }
    if (cs != 1.0f) {
#pragma unroll
        for (int i = 0; i < 16; ++i) v[i] = v[i] * cs;
    }
#pragma unroll
    for (int hlf = 0; hlf < 2; ++hlf) {
#pragma unroll
        for (int i = 0; i < 8; ++i) { LAS float* p = scr + (4 * i + rq) * 65 + c4 * 4; const f32x4 x = v[8 * hlf + i]; p[0] = x.x; p[1] = x.y; p[2] = x.z; p[3] = x.w; }
        asm volatile("s_waitcnt lgkmcnt(0)" ::: "memory");
        const int c = lane & 3;
#pragma unroll
        for (int j = 0; j < 4; ++j) { const int n = (lane >> 2) + 16 * j; const LAS float* s = scr + (8 * c) * 65 + n;
            u32x4 o; o.x = pk2(s[0 * 65], s[1 * 65]); o.y = pk2(s[2 * 65], s[3 * 65]); o.z = pk2(s[4 * 65], s[5 * 65]); o.w = pk2(s[6 * 65], s[7 * 65]);
            *(u32x4*)(dst + (size_t)(v0 + n) * dpitch + k0 + 32 * hlf + 8 * c) = o; EPI_FENCE(); }
        asm volatile("s_waitcnt lgkmcnt(0)" ::: "memory");
    }
}
constexpr int I_W1 = 16 * 64, I_WV = 16 * 16, I_WF = 8 * 16, I_WM = 8 * 16, I_WO = 16 * 16, I_WPG = 16 * 16, I_WPP = 4 * 16, I_GU = 32 * 16 * 8, I_D = 32 * 8 * 16;
constexpr int P0_NIT = I_W1 + I_WV + I_WF + I_WM + I_WO + I_WPG + I_WPP + 2 * I_GU + I_D, P0_EARLY = I_W1 + I_WV;
constexpr int CONV_CHUNK = 64, N_CONV_CHUNKS = (P0_NIT - P0_EARLY + CONV_CHUNK - 1) / CONV_CHUNK;
static_assert(10 * N_CONV_CHUNKS >= 2048, "the interleaved attention queue must cover all 2048 attention units");
template <int STAGE>
__device__ __forceinline__ void p0_weight_item(f32x4 (&v)[16], const Args& a, int it, LAS float* scr, int lane) {
    unsigned char* ws = a.ws;
            int r = it;
            if (r < I_W1) { const int kb = r >> 6, nb = r & 63, v0 = nb * 64; int s0, s1;
                if (v0 < 1024) { s0 = v0; s1 = v0 + 32; }
                else if (v0 < 2048) { const int u = v0 - 1024, sec = u >> 9, uu = u & 511, tile = uu >> 8, w = uu & 255, bj = w >> 7, u2 = w & 127;
                    s0 = 1536 + sec * 512 + tile * 256 + (u2 >> 5) * 64 + bj * 32; s1 = s0 + 64; }
                else if (v0 < 3072) { s0 = 3080 + (v0 - 2048); s1 = s0 + 32; }
                else { s0 = 4104 + (v0 - 3072); s1 = s0 + 32; }
                p0_item<STAGE>(v, a.in[3], INC, s0, s1, kb * 64, (bf16_t*)(ws + WS_W1), v0, 1024, nullptr, scr, lane, v0 >= 2048 ? -1.4426950408889634f : 1.0f); return; } r -= I_W1;
            if (r < I_WV) { const int kb = r >> 4, nb = r & 15, v0 = nb * 64; const int s0 = (v0 < 512) ? (1024 + v0) : (2560 + (v0 - 512));
                p0_item<STAGE>(v, a.in[3], INC, s0, s0 + 32, kb * 64, (bf16_t*)(ws + WS_WV), v0, 1024, nullptr, scr, lane); return; } r -= I_WV;
            if (r < I_WF) { const int kb = r >> 4, nb = r & 15; p0_item<STAGE>(v, a.in[5], 1024, nb * 64, nb * 64 + 32, kb * 64, (bf16_t*)(ws + WS_WF), nb * 64, 512, nullptr, scr, lane); return; } r -= I_WF;
            if (r < I_WM) { const int kb = r >> 4, nb = r & 15; p0_item<STAGE>(v, a.in[6], 1024, nb * 64, nb * 64 + 32, kb * 64, (bf16_t*)(ws + WS_WM), nb * 64, 512, nullptr, scr, lane); return; } r -= I_WM;
            if (r < I_WO) { const int kb = r >> 4, nb = r & 15; p0_item<STAGE>(v, a.in[7], 1024, nb * 64, nb * 64 + 32, kb * 64, (bf16_t*)(ws + WS_WO), nb * 64, 1024, nullptr, scr, lane); return; } r -= I_WO;
            if (r < I_WPG) { const int kb = r >> 4, nb = r & 15; p0_item<STAGE>(v, a.in[17], 1024, nb * 64, nb * 64 + 32, kb * 64, (bf16_t*)(ws + WS_WPG), nb * 64, 1024, a.in[16], scr, lane); return; } r -= I_WPG;
            if (r < I_WPP) { const int kb = r >> 4, nb = r & 15; p0_item<STAGE>(v, a.in[18], 1024, nb * 64, nb * 64 + 32, kb * 64, (bf16_t*)(ws + WS_WPP), nb * 64, 256, nullptr, scr, lane); return; } r -= I_WPP;
            if (r < I_GU) { const int e = r >> 7, q = r & 127, kb = q >> 3, nb = q & 7;
                p0_item<STAGE>(v, a.in[13] + (size_t)e * DM * DE, DE, nb * 64, nb * 64 + 32, kb * 64, (bf16_t*)(ws + WS_WG) + (size_t)e * DE * DM, nb * 64, 1024, a.in[8], scr, lane); return; } r -= I_GU;
            if (r < I_GU) { const int e = r >> 7, q = r & 127, kb = q >> 3, nb = q & 7;
                p0_item<STAGE>(v, a.in[14] + (size_t)e * DM * DE, DE, nb * 64, nb * 64 + 32, kb * 64, (bf16_t*)(ws + WS_WU) + (size_t)e * DE * DM, nb * 64, 1024, a.in[8], scr, lane); return; } r -= I_GU;
            { const int e = r >> 7, q = r & 127, kb = q >> 4, nb = q & 15;
                p0_item<STAGE>(v, a.in[15] + (size_t)e * DE * DM, DM, nb * 64, nb * 64 + 32, kb * 64, (bf16_t*)(ws + WS_WD) + (size_t)e * DM * DE, nb * 64, 512, nullptr, scr, lane); }
}


__device__ __forceinline__ void p0_weight_run(const Args& a, int it0, int step, int n, LAS float* scr, int lane) {
    f32x4 vA[16], vB[16];
    if (n > 0) p0_weight_item<0>(vA, a, it0, scr, lane);
    for (int i = 0; i < n; i += 2) {
        if (i + 1 < n) p0_weight_item<0>(vB, a, it0 + (i + 1) * step, scr, lane);
        p0_weight_item<1>(vA, a, it0 + i * step, scr, lane);
        if (i + 1 < n) { if (i + 2 < n) p0_weight_item<0>(vA, a, it0 + (i + 2) * step, scr, lane); p0_weight_item<1>(vB, a, it0 + (i + 1) * step, scr, lane); }
    }
}

__device__ __forceinline__ void phase0(const Ctx& C, const Args& a) {
    const int tid_ = opaque_tid(C), lane_ = tid_ & 63;
    unsigned char* ws = a.ws;
    const int gw = C.vcu * 8 + C.wave, NGW = C.G * 8;
    LAS float* wfl = (LAS float*)(C.lds + 73728);
    for (int idx = tid_; idx < 8192; idx += 512) { const int k = idx >> 3, c = idx & 7; wfl[c * 1024 + k] = a.in[3][(size_t)k * INC + 3072 + c]; }
    __syncthreads();
    {
        const float* g = a.in[2]; const float* bfg = a.in[4];
        bf16_t* HB = (bf16_t*)(ws + WS_HB); float* LOGF = (float*)(ws + WS_LOGF);
        f32x4 gv[4];
#pragma unroll
        for (int j = 0; j < 4; ++j) gv[j] = *(const f32x4*)(g + 4 * lane_ + 256 * j);
        f32x4 vn[4];
        if (gw < T) {
#pragma unroll
            for (int j = 0; j < 4; ++j) vn[j] = ((const f32x4*)(a.in[0] + (size_t)gw * DM) + lane_)[64 * j]; }
        for (int t = gw; t < T; t += NGW) {
            f32x4 v[4]; float ss = 0.f;
#pragma unroll
            for (int j = 0; j < 4; ++j) v[j] = vn[j];
            if (t + NGW < T) {
#pragma unroll
                for (int j = 0; j < 4; ++j) vn[j] = ((const f32x4*)(a.in[0] + (size_t)(t + NGW) * DM) + lane_)[64 * j]; }
#pragma unroll
            for (int j = 0; j < 4; ++j) ss += (v[j].x * v[j].x + v[j].y * v[j].y) + (v[j].z * v[j].z + v[j].w * v[j].w);
            const float rstd = 1.0f / sqrtf(wave_sum(ss) * (1.0f / DM) + RMS_EPS);
            unsigned long long* o8 = (unsigned long long*)(HB + (size_t)t * DM) + lane_;
#pragma unroll
            for (int j = 0; j < 4; ++j) { v[j] = v[j] * rstd * gv[j]; o8[64 * j] = (unsigned long long)pk2(v[j].x, v[j].y) | ((unsigned long long)pk2(v[j].z, v[j].w) << 32); }
            float fl[8];
#pragma unroll
            for (int c = 0; c < 8; ++c) { float s = 0.f;
#pragma unroll
                for (int j = 0; j < 4; ++j) { const f32x4 w = *(LAS const f32x4*)(wfl + c * 1024 + 4 * lane_ + 256 * j); s += (v[j].x * w.x + v[j].y * w.y) + (v[j].z * w.z + v[j].w * w.w); }
                fl[c] = wave_sum(s); }
            if (lane_ < 8) {
                float z = 0.f;
#pragma unroll
                for (int c = 0; c < 8; ++c) z = (lane_ == c) ? fl[c] : z;
                z += bfg[lane_];
                const float ls = (z >= 0.f) ? -log1pf(expf(-z)) : (z - log1pf(expf(z)));
                const int b = t >> 12, s_ = t & 4095;
                LOGF[(size_t)(b * 8 + lane_) * SEQ + s_] = ls;
            }
        }
    }
    {
        float* COS = (float*)(ws + WS_COS); float* SIN = (float*)(ws + WS_SIN);
        for (int idx = C.vcu * 512 + tid_; idx < SEQ * 32; idx += C.G * 512) {
            const int pos = idx >> 5, i = idx & 31;
            const double inv = exp(-(double)i * (1.0 / 32.0) * 9.210340371976184);
            const double ang = (double)pos * inv;
            double sn, cs; sincos(ang, &sn, &cs);
            COS[idx] = (float)cs; SIN[idx] = (float)sn;
        }
    }
    {
        bf16_t* WRH = (bf16_t*)(ws + WS_WRH); bf16_t* WRL = (bf16_t*)(ws + WS_WRL);
        for (int idx = C.vcu * 512 + tid_; idx < 32 * 3 * 64 * 8; idx += C.G * 512) {
            const int j = idx & 7, ln = (idx >> 3) & 63, nf = (idx >> 9) % 3, ks = (idx >> 9) / 3;
            const int n = 16 * nf + (ln & 15), k = 32 * ks + 8 * (ln >> 4) + j;
            float v = 0.f;
            if (n < 4) v = a.in[9][k * 4 + n]; else if (n < 36) v = a.in[11][k * 32 + (n - 4)];
            v *= a.in[8][k];
            const unsigned h = pk2(v, 0.f) & 0xffffu; const float hf = __builtin_bit_cast(float, h << 16);
            WRH[idx] = (bf16_t)h; WRL[idx] = (bf16_t)(pk2(v - hf, 0.f) & 0xffffu);
        }
    }
    {
        LAS float* scr = (LAS float*)(C.lds + C.wave * 8704);
        { const int gw2 = C.wave * C.G + C.vcu;
          const int n = (gw2 < P0_EARLY) ? (P0_EARLY - gw2 + NGW - 1) / NGW : 0; p0_weight_run(a, gw2, NGW, n, scr, lane_); }
    }
}

__device__ __forceinline__ void p1_cumsum(const Ctx& C, const Args& a) {
    const int tid_ = opaque_tid(C), lane_ = tid_ & 63;
    if (C.vcu < 64) {
        const float* LOGF = (const float*)(a.ws + WS_LOGF) + (size_t)C.vcu * SEQ; float* C2 = (float*)(a.ws + WS_C2) + (size_t)C.vcu * SEQ;
        LAS double* wsum = (LAS double*)(C.lds);
        const f32x4 v0 = *(const f32x4*)(LOGF + 8 * tid_), v1 = *(const f32x4*)(LOGF + 8 * tid_ + 4);
        const double e[8] = {(double)v0.x, (double)v0.y, (double)v0.z, (double)v0.w, (double)v1.x, (double)v1.y, (double)v1.z, (double)v1.w};
        double loc = 0.0;
#pragma unroll
        for (int i = 0; i < 8; ++i) loc += e[i];
        double inc = loc;
#pragma unroll
        for (int o = 1; o < 64; o <<= 1) { const double nb = __shfl_up(inc, o); if (lane_ >= o) inc += nb; }
        if (lane_ == 63) wsum[C.wave] = inc;
        __syncthreads();
        double run = inc - loc;
        for (int w = 0; w < C.wave; ++w) run += wsum[w];
        float o8[8];
#pragma unroll
        for (int i = 0; i < 8; ++i) { run += e[i]; o8[i] = (float)(run * 1.4426950408889634); }
        *(f32x4*)(C2 + 8 * tid_) = (f32x4){o8[0], o8[1], o8[2], o8[3]}; *(f32x4*)(C2 + 8 * tid_ + 4) = (f32x4){o8[4], o8[5], o8[6], o8[7]};
        __syncthreads();
    }
}

template <bool ISK>
__device__ __forceinline__ void rope_epi(unsigned char* ws, Acc& acc, int pm, int pn, int rowt, int wr, int wc, int fr, int fq) {
    bf16_t* O = (bf16_t*)(ws + (ISK ? WS_KM : WS_QM)); const float sc = ISK ? 1.0f : QSCALE;
    const float* COS = (const float*)(ws + WS_COS); const float* SIN = (const float*)(ws + WS_SIN);
    const int head = 4 * (pn & 1) + wc;
    f32x4 cs1[2] = {{0.f, 0.f, 0.f, 0.f}, {0.f, 0.f, 0.f, 0.f}}, cs2[2] = {{0.f, 0.f, 0.f, 0.f}, {0.f, 0.f, 0.f, 0.f}};
#pragma unroll
    for (int ai = 0; ai < 2; ++ai)
#pragma unroll
        for (int m = 0; m < 4; ++m) { const int row = rowt + 128 * ai + RL(m, fr); const int pos = row & (SEQ - 1);
            bf16_t* rp = O + ((size_t)((row >> 12) * 8 + head) * SEQ + pos) * 64 + 8 * fq;
            u32x4 lo4, hi4;
#pragma unroll
            for (int n = 0; n < 2; ++n) { const f32x4 co = *(const f32x4*)(COS + pos * 32 + 4 * n + 8 * fq), si = *(const f32x4*)(SIN + pos * 32 + 4 * n + 8 * fq);
                const f32x4 x1 = acc[ai][0][m][n], x2 = acc[ai][1][m][n];
                const f32x4 o1 = x1 * co - x2 * si, o2 = x2 * co + x1 * si;
                if (ISK) { cs1[n] += o1; cs2[n] += o2; asm volatile("" : "+v"(cs1[n]), "+v"(cs2[n])); }
                const f32x4 w1 = o1 * sc, w2 = o2 * sc;
                lo4[2 * n] = pk2(w1.x, w1.y); lo4[2 * n + 1] = pk2(w1.z, w1.w); hi4[2 * n] = pk2(w2.x, w2.y); hi4[2 * n + 1] = pk2(w2.z, w2.w); }
            *(u32x4*)(rp) = lo4; *(u32x4*)(rp + 32) = hi4;
            EPI_FENCE(); }
    if (ISK) {
        float* KMP = (float*)(ws + WS_KMP) + (size_t)(pm * 2 + wr) * 512 + head * 64;
#pragma unroll
        for (int n = 0; n < 2; ++n)
#pragma unroll
            for (int j = 0; j < 4; ++j) { float v1 = cs1[n][j], v2 = cs2[n][j];
#pragma unroll
                for (int o = 1; o < 16; o <<= 1) { v1 += __shfl_xor(v1, o); v2 += __shfl_xor(v2, o); }
                if (fr == 0) { KMP[4 * n + 8 * fq + j] = v1; KMP[32 + 4 * n + 8 * fq + j] = v2; }
                EPI_FENCE(); }
    }
}

__device__ __forceinline__ void p1_epi_proj(unsigned char* ws, Acc& acc, int pm, int pn, int wr, int wc, int fr, int fq) {
    const int lane = fr + 16 * fq;
    const int rowt = pm * 256 + 64 * wr;
    if (pn < 4) {
        bf16_t* O = (bf16_t*)(ws + (pn < 2 ? WS_QF : WS_KF)); const float sc = (pn < 2) ? QSCALE : 1.0f; const int cb = (pn & 1) * 256 + 32 * wc + 8 * fq;
#pragma unroll
        for (int ai = 0; ai < 2; ++ai)
#pragma unroll
            for (int m = 0; m < 4; ++m) { const int row = rowt + 128 * ai + RL(m, fr);
#pragma unroll
                for (int bj = 0; bj < 2; ++bj) { bf16_t* rp = O + ((size_t)((row >> 12) * 8 + 4 * (pn & 1) + 2 * bj + (wc >> 1)) * SEQ + (row & (SEQ - 1))) * 64 + 32 * (wc & 1) + 8 * fq;
#pragma unroll
                    for (int n = 0; n < 2; ++n) { const f32x4 v = acc[ai][bj][m][n] * sc; *(u32x2*)(rp + 4 * n) = (u32x2){pk2(v.x, v.y), pk2(v.z, v.w)}; } } EPI_FENCE(); }
        if (pn >= 2) {
            unsigned* KMX = (unsigned*)(ws + WS_CTL) + CW_KMAX;
#pragma unroll
            for (int bj = 0; bj < 2; ++bj) { float mx = 0.f;
#pragma unroll
                for (int ai = 0; ai < 2; ++ai)
#pragma unroll
                    for (int m = 0; m < 4; ++m) { const f32x4 u = acc[ai][bj][m][0], w = acc[ai][bj][m][1];
                        float ssq = (u.x * u.x + u.y * u.y) + (u.z * u.z + u.w * u.w) + (w.x * w.x + w.y * w.y) + (w.z * w.z + w.w * w.w);
                        ssq += __shfl_xor(ssq, 16); ssq += __shfl_xor(ssq, 32); mx = fmaxf(mx, ssq); }
#pragma unroll
                for (int o = 1; o < 16; o <<= 1) mx = fmaxf(mx, __shfl_xor(mx, o));
                if (lane == 0) atomicMax(KMX + 64 * (((pm >> 4) * 8 + 4 * (pn & 1) + 2 * bj + (wc >> 1)) * 2 + (wc & 1)), __float_as_uint(mx));
                EPI_FENCE(); }
        }
    } else if (pn < 6) { rope_epi<false>(ws, acc, pm, pn, rowt, wr, wc, fr, fq);
    } else if (pn < 8) { rope_epi<true>(ws, acc, pm, pn, rowt, wr, wc, fr, fq);
    } else {
        bf16_t* O = (bf16_t*)(ws + (pn < 12 ? WS_SA : WS_SB)); const int cb = ((pn - 8) & 3) * 256 + 32 * wc + 8 * fq;
#pragma unroll
        for (int ai = 0; ai < 2; ++ai)
#pragma unroll
            for (int m = 0; m < 4; ++m) { bf16_t* rp = O + (size_t)(rowt + 128 * ai + RL(m, fr)) * DM + cb;
#pragma unroll
                for (int bj = 0; bj < 2; ++bj)
#pragma unroll
                    for (int n = 0; n < 2; ++n) { const f32x4 v = acc[ai][bj][m][n];
                        *(u32x2*)(rp + 128 * bj + 4 * n) = (u32x2){pk2(v.x, v.y), pk2(v.z, v.w)}; } EPI_FENCE(); }
    }
}
__device__ __forceinline__ void p1_epi_vt(unsigned char* ws, Acc& acc, int pmf, int pnt, int wr, int wc, int fr, int fq) {
    bf16_t* VT = (bf16_t*)(ws + WS_VT);
    const int tok0 = pnt * 256, b = tok0 >> 12, s0 = (tok0 & (SEQ - 1)) + 32 * wc + 8 * fq;
#pragma unroll
    for (int ai = 0; ai < 2; ++ai)
#pragma unroll
        for (int m = 0; m < 4; ++m) { const int f = pmf * 256 + 128 * ai + 64 * wr + RL(m, fr); const int type = f >> 9, hh = (f >> 6) & 7, d = f & 63;
            bf16_t* rp = VT + (size_t)((type * 8 + b) * 8 + hh) * 64 * SEQ + d * 64;
#pragma unroll
            for (int bj = 0; bj < 2; ++bj)
                { const f32x4 v = acc[ai][bj][m][0], w = acc[ai][bj][m][1]; const int s = s0 + 128 * bj;
                  *(u32x4*)(rp + (size_t)(s >> 6) * 4096 + (s & 63)) = (u32x4){pk2(v.x, v.y), pk2(v.z, v.w), pk2(w.x, w.y), pk2(w.z, w.w)}; } EPI_FENCE(); }
}

struct P1Sched {
    const char* H; const char* W1; const char* WV; int vcu, G;
    __device__ __forceinline__ bool next(int i, pg8::GUnit& u) const {
        const int L = i * G + vcu; if (L >= 2560) return false;
        if (L < 2048) { const int pm = L >> 4, pn = (L + ((G & 15) ? 0 : 2 * i)) & 15; u.x0 = pm; u.x1 = pn; u.x2 = 0; u.x3 = 0;
            u.a0 = H + (size_t)pm * 256 * 2048; u.a1 = u.a0 + (size_t)128 * 2048; u.b0 = W1 + (size_t)pn * 256 * 2048; u.b1 = u.b0 + (size_t)128 * 2048; }
        else { const int Lv = L - 2048, pmf = Lv & 3, pnt = Lv >> 2; u.x0 = pmf; u.x1 = pnt; u.x2 = 1; u.x3 = 0;
            u.a0 = WV + (size_t)pmf * 256 * 2048; u.a1 = u.a0 + (size_t)128 * 2048; u.b0 = H + (size_t)pnt * 256 * 2048; u.b1 = u.b0 + (size_t)128 * 2048; }
        return true; }
};
struct P1Epi {
    unsigned char* ws;
    __device__ __forceinline__ void operator()(Acc& acc, const pg8::GUnit& u, int wr, int wc, int fr, int fq) const {
        if (u.x2 == 0) p1_epi_proj(ws, acc, u.x0, u.x1, wr, wc, fr, fq); else p1_epi_vt(ws, acc, u.x0, u.x1, wr, wc, fr, fq); }
};

constexpr int AL_K = 0, AL_V = 16384, AL_C = 42496, AL_VOTE = 43008, AL_V_STRIDE = 136, AL_VB = 8704;
template <bool LAG, int type>
__device__ __forceinline__ void attn_tile(LAS unsigned char* L, const int t, const int kv0, const int q0, const int qpos, const int q32, const int hi, const int qb, const unsigned sel,
                                          const float base, const bf16x8 (&qf)[4], f32x16& negm, f32x16& o0, f32x16& o1, float& mref, f32x16& osum, bf16x8 (&pend)[2][2], int& tpend, f32x16& cinp, int& cin_blk) {
    const int kroff = q32 * 128, ksw = (q32 >> 1) & 7; const int cur = t & 1;
    const short one_ = (q32 == 0) ? (short)0x3F80 : (short)0; const bf16x8 vones = {one_, one_, one_, one_, one_, one_, one_, one_};
    if (LAG && tpend >= 0) {
        LAS const unsigned char* Vp = L + AL_V + (tpend % 3) * AL_VB;
        bf16x8 wfa[2][2], wfc[2][2];
#pragma unroll
        for (int blk = 0; blk < 2; ++blk)
#pragma unroll
            for (int s = 0; s < 2; ++s) {
                LAS const unsigned char* vp = Vp + q32 * AL_V_STRIDE + (32 * blk + 16 * s + 4 * hi) * 2;
                const s16x4 a0 = *(LAS const s16x4*)(vp), a1 = *(LAS const s16x4*)(vp + 16);
                const s16x4 c0 = *(LAS const s16x4*)(vp + 32 * AL_V_STRIDE), c1 = *(LAS const s16x4*)(vp + 32 * AL_V_STRIDE + 16);
                wfa[blk][s] = (bf16x8){a0[0], a0[1], a0[2], a0[3], a1[0], a1[1], a1[2], a1[3]};
                wfc[blk][s] = (bf16x8){c0[0], c0[1], c0[2], c0[3], c1[0], c1[1], c1[2], c1[3]};
            }
        __builtin_amdgcn_sched_barrier(0);
#pragma unroll
        for (int blk = 0; blk < 2; ++blk)
#pragma unroll
            for (int s = 0; s < 2; ++s) {
                o0 = __builtin_amdgcn_mfma_f32_32x32x16_bf16(wfa[blk][s], pend[blk][s], o0, 0, 0, 0);
                o1 = __builtin_amdgcn_mfma_f32_32x32x16_bf16(wfc[blk][s], pend[blk][s], o1, 0, 0, 0);
                osum = __builtin_amdgcn_mfma_f32_32x32x16_bf16(vones, pend[blk][s], osum, 0, 0, 0);
            }
        tpend = -1;
    }
        if (kv0 <= q0 + 31) {
            LAS const unsigned char* Kb = L + AL_K + cur * 8192; LAS const unsigned char* Vb = L + AL_V + (t % 3) * AL_VB; LAS const float* Cb = (LAS const float*)(L + AL_C + cur * 256);
            const int nblk = kv0 >> 8;
            const bool unsel = (type == 1) && (nblk < qb) && !((sel >> nblk) & 1u);
            if (type == 1 && cin_blk != nblk) { cin_blk = nblk;
#pragma unroll
                for (int r = 0; r < 16; ++r) cinp[r] = unsel ? -INFINITY : negm[r]; }
            const f32x16 cin = (type == 1) ? cinp : negm;
            f32x16 p0, p1;
#pragma unroll
            for (int kh = 0; kh < 2; ++kh) {
                bf16x8 kfa[2], kfb[2];
#pragma unroll
                for (int k2 = 0; k2 < 2; ++k2) { const int ks = 2 * kh + k2; kfa[k2] = *(LAS const bf16x8*)(Kb + kroff + (((2 * ks + hi) ^ ksw) * 16)); kfb[k2] = *(LAS const bf16x8*)(Kb + 4096 + kroff + (((2 * ks + hi) ^ ksw) * 16)); }
                __builtin_amdgcn_sched_barrier(0);
#pragma unroll
                for (int k2 = 0; k2 < 2; ++k2) { const int ks = 2 * kh + k2;
                    p0 = __builtin_amdgcn_mfma_f32_32x32x16_bf16(kfa[k2], qf[ks], ks == 0 ? cin : p0, 0, 0, 0);
                    p1 = __builtin_amdgcn_mfma_f32_32x32x16_bf16(kfb[k2], qf[ks], ks == 0 ? cin : p1, 0, 0, 0); }
                __builtin_amdgcn_sched_barrier(0);
            }
            bf16x8 vfa[2][2], vfc[2][2];
            if (!LAG)
#pragma unroll
            for (int blk = 0; blk < 2; ++blk)
#pragma unroll
                for (int s = 0; s < 2; ++s) {
                    LAS const unsigned char* vp = Vb + q32 * AL_V_STRIDE + (32 * blk + 16 * s + 4 * hi) * 2;
                    const s16x4 a0 = *(LAS const s16x4*)(vp), a1 = *(LAS const s16x4*)(vp + 16);
                    const s16x4 c0 = *(LAS const s16x4*)(vp + 32 * AL_V_STRIDE), c1 = *(LAS const s16x4*)(vp + 32 * AL_V_STRIDE + 16);
                    vfa[blk][s] = (bf16x8){a0[0], a0[1], a0[2], a0[3], a1[0], a1[1], a1[2], a1[3]};
                    vfc[blk][s] = (bf16x8){c0[0], c0[1], c0[2], c0[3], c1[0], c1[1], c1[2], c1[3]};
                }
            __builtin_amdgcn_sched_barrier(0);
            if (type == 0) {
#pragma unroll
                for (int gh = 0; gh < 2; ++gh) {
#pragma unroll
                    for (int g2 = 0; g2 < 2; ++g2) { const int g = 2 * gh + g2; const f32x4 c0 = *(LAS const f32x4*)(Cb + 8 * g + 4 * hi), c1 = *(LAS const f32x4*)(Cb + 32 + 8 * g + 4 * hi);
#pragma unroll
                        for (int j = 0; j < 4; ++j) { p0[4 * g + j] -= c0[j]; p1[4 * g + j] -= c1[j]; } }
                    __builtin_amdgcn_sched_barrier(0); }
            }
            const bool diag = (kv0 + 63 > q0);
            if (diag) {
                int qp2 = qpos; asm volatile("" : "+v"(qp2));
#pragma unroll
                for (int r = 0; r < 16; ++r) { const int kv = kv0 + (r & 3) + 8 * (r >> 2) + 4 * hi; if (kv > qp2) p0[r] = -INFINITY; if (kv + 32 > qp2) p1[r] = -INFINITY; }
            }
            float ra = __builtin_fmaxf(__builtin_fmaxf(p0[0], p0[1]), p0[2]), rb = __builtin_fmaxf(__builtin_fmaxf(p1[0], p1[1]), p1[2]);
#pragma unroll
            for (int r = 3; r < 15; r += 2) { ra = __builtin_fmaxf(__builtin_fmaxf(ra, p0[r]), p0[r + 1]); rb = __builtin_fmaxf(__builtin_fmaxf(rb, p1[r]), p1[r + 1]); }
            float rm = __builtin_fmaxf(__builtin_fmaxf(ra, rb), __builtin_fmaxf(p0[15], p1[15]));
            rm = xhalf_max(rm);
            if (__any(rm > 8.0f)) {
                const float d = __builtin_fmaxf(rm, 0.f);
                mref += d;
                const float alpha = __builtin_amdgcn_exp2f(-d);
                osum[0] *= alpha;
#pragma unroll
                for (int r = 0; r < 16; ++r) { p0[r] -= d; p1[r] -= d; o0[r] *= alpha; o1[r] *= alpha; negm[r] = base - mref; }
                cin_blk = -1;
            }
#pragma unroll
            for (int r = 0; r < 16; ++r) { p0[r] = __builtin_amdgcn_exp2f(p0[r]); p1[r] = __builtin_amdgcn_exp2f(p1[r]); }
            bf16x8 pb[2][2];
#pragma unroll
            for (int s = 0; s < 2; ++s) {
                u32x4 w0 = {pk2(p0[8 * s + 0], p0[8 * s + 1]), pk2(p0[8 * s + 2], p0[8 * s + 3]), pk2(p0[8 * s + 4], p0[8 * s + 5]), pk2(p0[8 * s + 6], p0[8 * s + 7])};
                u32x4 w1 = {pk2(p1[8 * s + 0], p1[8 * s + 1]), pk2(p1[8 * s + 2], p1[8 * s + 3]), pk2(p1[8 * s + 4], p1[8 * s + 5]), pk2(p1[8 * s + 6], p1[8 * s + 7])};
                pb[0][s] = __builtin_bit_cast(bf16x8, w0); pb[1][s] = __builtin_bit_cast(bf16x8, w1);
            }
            if (LAG) { pend[0][0] = pb[0][0]; pend[0][1] = pb[0][1]; pend[1][0] = pb[1][0]; pend[1][1] = pb[1][1]; tpend = t; }
            else {
#pragma unroll
            for (int blk = 0; blk < 2; ++blk)
#pragma unroll
                for (int s = 0; s < 2; ++s) {
                    o0 = __builtin_amdgcn_mfma_f32_32x32x16_bf16(vfa[blk][s], pb[blk][s], o0, 0, 0, 0);
                    o1 = __builtin_amdgcn_mfma_f32_32x32x16_bf16(vfc[blk][s], pb[blk][s], o1, 0, 0, 0);
                    osum = __builtin_amdgcn_mfma_f32_32x32x16_bf16(vones, pb[blk][s], osum, 0, 0, 0);
                }
            }
        }
}

template <bool LAG, int type>
__device__ __forceinline__ void attn_loop(LAS unsigned char* L, volatile LAS unsigned* VOTE, const int nt, const int tid, const int lane, const int wid, const int q0, const int qpos, const int q32, const int hi,
                                          const int qb, const unsigned sel, const float base, const float qkb, const bf16x8 (&qf)[4], const bf16_t* ksrc, const bf16_t* vsrc, const float* C2, const int kwoff, const int vwoff,
                                          u32x4 rk, u32x4 rv, float rc, f32x16& negm, f32x16& o0, f32x16& o1, float& mref, f32x16& osum) {
    bf16x8 pend[2][2]; int tpend = -1; f32x16 cinp = negm; int cin_blk = -1;
    const int tw = (q0 + 31) >> 6;
#pragma unroll
    for (int i_ = 0; i_ < 2; ++i_)
#pragma unroll
        for (int j_ = 0; j_ < 2; ++j_) pend[i_][j_] = (bf16x8){0, 0, 0, 0, 0, 0, 0, 0};
    for (int t = nt - 1; t >= 0; --t) {
        const int cur = t & 1;
        const int kv0 = t * 64;
        bool more = (t > 0);
        if (type == 0 && t < nt - 1 && more) {
            unsigned any = 0u;
#pragma unroll
            for (int w8 = 0; w8 < 8; ++w8) any |= VOTE[(((t + 1) & 1) * 8 + w8)];
            more = (any != 0u);
        }
        if (more) { rk = *(const u32x4*)(ksrc + (size_t)(t - 1) * 4096); rv = *(const u32x4*)(vsrc + (size_t)(t - 1) * 4096); if (type == 0 && tid < 64) rc = C2[kv0 - 64 + tid]; }
        attn_tile<LAG, type>(L, t, kv0, q0, qpos, q32, hi, qb, sel, base, qf, negm, o0, o1, mref, osum, pend, tpend, cinp, cin_blk);
        if (type == 0 && t >= 2) {
            const float clim = C2[(t - 1) * 64 - 1];
            const bool need = (t > tw) || !(qkb - clim < mref - 40.0f);
            const unsigned long long nb = __ballot(need);
            if (lane == 0) VOTE[(t & 1) * 8 + wid] = (nb != 0ull) ? 1u : 0u;
        }
        if (!more) break;
        {
            const int nx = cur ^ 1, vx = (t + 2) % 3;
            *(LAS u32x4*)(L + AL_K + nx * 8192 + kwoff) = rk;
            *(LAS u32x2*)(L + AL_V + vx * AL_VB + vwoff) = (u32x2){rv.x, rv.y}; *(LAS u32x2*)(L + AL_V + vx * AL_VB + vwoff + 8) = (u32x2){rv.z, rv.w};
            if (type == 0 && tid < 64) *(LAS float*)(L + AL_C + nx * 256 + tid * 4) = rc;
        }
        __syncthreads();
    }
    if (LAG && tpend >= 0) attn_tile<true, type>(L, -1, 1 << 30, q0, qpos, q32, hi, qb, sel, base, qf, negm, o0, o1, mref, osum, pend, tpend, cinp, cin_blk);
}


__device__ __forceinline__ void moba_select4(const Ctx& C, const Args& a, const int task0, const int tstep) {
    const int tid = opaque_tid(C), lane = tid & 63, q32 = lane & 31, hi = lane >> 5;
    unsigned char* ws = a.ws;
    LAS float* KMT = (LAS float*)C.lds;
    int qbk[4], bhk[4]; bf16x8 qf[4][4];
#pragma unroll
    for (int k = 0; k < 4; ++k) { const int task = task0 + k * tstep; const bool ok = task < 64 * 16 * 8;
        qbk[k] = ok ? (task >> 3) & 15 : 0; bhk[k] = ok ? task >> 7 : 0;
        const int b = bhk[k] >> 3, h = bhk[k] & 7;
        if (qbk[k] >= 4) {
            for (int i = tid; i < qbk[k] * 64; i += 512) { const int n = i >> 6, d = i & 63; const float* km0 = (const float*)(ws + WS_KMP) + (size_t)((b * 16 + n) * 2) * 512 + h * 64 + d; KMT[k * 1024 + i] = km0[0] + km0[512]; }
            const bf16_t* qp = (const bf16_t*)(ws + WS_QM) + ((size_t)bhk[k] * SEQ + qbk[k] * 256 + 32 * (task & 7) + q32) * 64 + hi * 8;
#pragma unroll
            for (int ks = 0; ks < 4; ++ks) qf[k][ks] = *(const bf16x8*)(qp + ks * 16);
        }
    }
    __syncthreads();
    unsigned pack[4];
#pragma unroll
    for (int k = 0; k < 4; ++k) { const int qb = qbk[k];
        if (qb <= 3) pack[k] = 0x210u | ((unsigned)qb << 12);
        else {
            float v1 = -INFINITY, v2 = -INFINITY, v3 = -INFINITY; int i1 = 0, i2 = 0, i3 = 0;
            for (int n = 0; n < qb; ++n) {
                LAS const float* km0 = KMT + k * 1024 + n * 64 + hi * 8;
                float g = 0.f;
#pragma unroll
                for (int ks = 0; ks < 4; ++ks) { const f32x4 ka = *(LAS const f32x4*)(km0 + ks * 16), kb = *(LAS const f32x4*)(km0 + ks * 16 + 4);
                    g += bf2f(qf[k][ks][0]) * ka.x + bf2f(qf[k][ks][1]) * ka.y + bf2f(qf[k][ks][2]) * ka.z + bf2f(qf[k][ks][3]) * ka.w
                       + bf2f(qf[k][ks][4]) * kb.x + bf2f(qf[k][ks][5]) * kb.y + bf2f(qf[k][ks][6]) * kb.z + bf2f(qf[k][ks][7]) * kb.w; }
                g = xhalf_sum(g);
                if (g > v1) { v3 = v2; i3 = i2; v2 = v1; i2 = i1; v1 = g; i1 = n; }
                else if (g > v2) { v3 = v2; i3 = i2; v2 = g; i2 = n; }
                else if (g > v3) { v3 = g; i3 = n; }
            }
            pack[k] = (unsigned)i1 | ((unsigned)i2 << 4) | ((unsigned)i3 << 8) | (3u << 12);
        }
    }
    unsigned mycnt[4], mybase[4];
#pragma unroll
    for (int k = 0; k < 4; ++k) { const unsigned ns = pack[k] >> 12; const int s0 = pack[k] & 15, s1 = (pack[k] >> 4) & 15, s2 = (pack[k] >> 8) & 15;
        mycnt[k] = 0u;
        for (int j = 0; j < qbk[k]; ++j) { const bool on = (hi == 0) && ((s0 == j) || (ns > 1u && s1 == j) || (ns > 2u && s2 == j));
            const unsigned long long m = __ballot(on); if (lane == j) mycnt[k] = (unsigned)__popcll(m); } }
#pragma unroll
    for (int k = 0; k < 4; ++k) { unsigned* LC = (unsigned*)(ws + WS_CTL) + CW_LCNT + 32 * (bhk[k] * 16);
        mybase[k] = 0u;
        if (lane < qbk[k] && mycnt[k] > 0u) mybase[k] = __hip_atomic_fetch_add(LC + 32 * lane, mycnt[k], __ATOMIC_RELAXED, __HIP_MEMORY_SCOPE_AGENT); }
#pragma unroll
    for (int k = 0; k < 4; ++k) { const unsigned ns = pack[k] >> 12; const int s0 = pack[k] & 15, s1 = (pack[k] >> 4) & 15, s2 = (pack[k] >> 8) & 15;
        const int qpos = qbk[k] * 256 + 32 * ((task0 + k * tstep) & 7) + q32;
        unsigned short* LIST = (unsigned short*)((unsigned char*)a.out + XS_LIST) + (size_t)(bhk[k] * 16) * LIST_CAP;
        for (int j = 0; j < qbk[k]; ++j) { const int r = (s0 == j) ? 0 : ((ns > 1u && s1 == j) ? 1 : ((ns > 2u && s2 == j) ? 2 : -1)); const bool on = (hi == 0) && (r >= 0);
            const unsigned long long m = __ballot(on); const unsigned bj = (unsigned)__builtin_amdgcn_readlane((int)mybase[k], j);
            if (on) { const unsigned pos = bj + (unsigned)__popcll(m & ((1ull << lane) - 1ull)); const unsigned val = (unsigned)(qpos | (r << 12));
                asm volatile("global_store_short %0, %1, off sc1\n\ts_nop 1" :: "v"(LIST + (size_t)j * LIST_CAP + pos), "v"(val) : "memory"); } } }
    asm volatile("s_waitcnt vmcnt(0)" ::: "memory");
    __syncthreads();
}

constexpr int ML_K = 0, ML_V = 32768;
__device__ __forceinline__ void moba_step(LAS const unsigned char* KbA, LAS const unsigned char* VbA, LAS const unsigned char* KbB, LAS const unsigned char* VbB, const bool diagA, const bool diagB, const int kv0A,
                                          const int qpos, const int q32, const int hi, const bf16x8 (&qf)[4], const f32x16& cin, f32x16& negm, f32x16& o0, f32x16& o1, float& mref, f32x16& osum, int& cin_blk) {
    const int kroff = q32 * 128, ksw = (q32 >> 1) & 7;
    const short one_ = (q32 == 0) ? (short)0x3F80 : (short)0; const bf16x8 vones = {one_, one_, one_, one_, one_, one_, one_, one_};
    constexpr bool TWO = true;
    f32x16 a0, a1, b0, b1;
#pragma unroll
    for (int tl = 0; tl < 2; ++tl) {
        LAS const unsigned char* Kb = tl ? KbB : KbA;
#pragma unroll
        for (int kh = 0; kh < 2; ++kh) {
            bf16x8 kfa[2], kfb[2];
#pragma unroll
            for (int k2 = 0; k2 < 2; ++k2) { const int ks = 2 * kh + k2; kfa[k2] = *(LAS const bf16x8*)(Kb + kroff + (((2 * ks + hi) ^ ksw) * 16)); kfb[k2] = *(LAS const bf16x8*)(Kb + 4096 + kroff + (((2 * ks + hi) ^ ksw) * 16)); }
            __builtin_amdgcn_sched_barrier(0);
#pragma unroll
            for (int k2 = 0; k2 < 2; ++k2) { const int ks = 2 * kh + k2;
                if (tl == 0) { a0 = __builtin_amdgcn_mfma_f32_32x32x16_bf16(kfa[k2], qf[ks], ks == 0 ? cin : a0, 0, 0, 0); a1 = __builtin_amdgcn_mfma_f32_32x32x16_bf16(kfb[k2], qf[ks], ks == 0 ? cin : a1, 0, 0, 0); }
                else         { b0 = __builtin_amdgcn_mfma_f32_32x32x16_bf16(kfa[k2], qf[ks], ks == 0 ? cin : b0, 0, 0, 0); b1 = __builtin_amdgcn_mfma_f32_32x32x16_bf16(kfb[k2], qf[ks], ks == 0 ? cin : b1, 0, 0, 0); } }
            __builtin_amdgcn_sched_barrier(0);
        }
    }
    if (diagA) {
        int qp2 = qpos; asm volatile("" : "+v"(qp2));
#pragma unroll
        for (int r = 0; r < 16; ++r) { const int kv = kv0A + (r & 3) + 8 * (r >> 2) + 4 * hi; if (kv > qp2) a0[r] = -INFINITY; if (kv + 32 > qp2) a1[r] = -INFINITY; }
    }
    if (diagB) {
        int qp2 = qpos; asm volatile("" : "+v"(qp2));
#pragma unroll
        for (int r = 0; r < 16; ++r) { const int kv = kv0A - 64 + (r & 3) + 8 * (r >> 2) + 4 * hi; if (kv > qp2) b0[r] = -INFINITY; if (kv + 32 > qp2) b1[r] = -INFINITY; }
    }
    float ra = __builtin_fmaxf(__builtin_fmaxf(a0[0], a0[1]), a0[2]), rb = __builtin_fmaxf(__builtin_fmaxf(a1[0], a1[1]), a1[2]);
#pragma unroll
    for (int r = 3; r < 15; r += 2) { ra = __builtin_fmaxf(__builtin_fmaxf(ra, a0[r]), a0[r + 1]); rb = __builtin_fmaxf(__builtin_fmaxf(rb, a1[r]), a1[r + 1]); }
    float rm = __builtin_fmaxf(__builtin_fmaxf(ra, rb), __builtin_fmaxf(a0[15], a1[15]));
    if (TWO) {
        float rc_ = __builtin_fmaxf(__builtin_fmaxf(b0[0], b0[1]), b0[2]), rd = __builtin_fmaxf(__builtin_fmaxf(b1[0], b1[1]), b1[2]);
#pragma unroll
        for (int r = 3; r < 15; r += 2) { rc_ = __builtin_fmaxf(__builtin_fmaxf(rc_, b0[r]), b0[r + 1]); rd = __builtin_fmaxf(__builtin_fmaxf(rd, b1[r]), b1[r + 1]); }
        rm = __builtin_fmaxf(rm, __builtin_fmaxf(__builtin_fmaxf(rc_, rd), __builtin_fmaxf(b0[15], b1[15])));
    }
    rm = xhalf_max(rm);
    if (__any(rm > 8.0f)) {
        const float d = (rm > 8.0f) ? rm : 0.f;
        mref += d;
        const float alpha = __builtin_amdgcn_exp2f(-d);
        osum[0] *= alpha;
#pragma unroll
        for (int r = 0; r < 16; ++r) { a0[r] -= d; a1[r] -= d; if (TWO) { b0[r] -= d; b1[r] -= d; } o0[r] *= alpha; o1[r] *= alpha; negm[r] = -mref; }
        cin_blk = -1;
    }
    __builtin_amdgcn_sched_barrier(0);
    bf16x8 vfa[2][2], vfc[2][2];
#pragma unroll
    for (int blk = 0; blk < 2; ++blk)
#pragma unroll
        for (int s = 0; s < 2; ++s) {
            LAS const unsigned char* vp = VbA + q32 * AL_V_STRIDE + (32 * blk + 16 * s + 4 * hi) * 2;
            const s16x4 x0 = *(LAS const s16x4*)(vp), x1 = *(LAS const s16x4*)(vp + 16);
            const s16x4 c0 = *(LAS const s16x4*)(vp + 32 * AL_V_STRIDE), c1 = *(LAS const s16x4*)(vp + 32 * AL_V_STRIDE + 16);
            vfa[blk][s] = (bf16x8){x0[0], x0[1], x0[2], x0[3], x1[0], x1[1], x1[2], x1[3]};
            vfc[blk][s] = (bf16x8){c0[0], c0[1], c0[2], c0[3], c1[0], c1[1], c1[2], c1[3]};
        }
    __builtin_amdgcn_sched_barrier(0);
#pragma unroll
    for (int r = 0; r < 16; ++r) { a0[r] = __builtin_amdgcn_exp2f(a0[r]); a1[r] = __builtin_amdgcn_exp2f(a1[r]); }
    bf16x8 pa[2][2];
#pragma unroll
    for (int s = 0; s < 2; ++s) {
        u32x4 w0 = {pk2(a0[8 * s + 0], a0[8 * s + 1]), pk2(a0[8 * s + 2], a0[8 * s + 3]), pk2(a0[8 * s + 4], a0[8 * s + 5]), pk2(a0[8 * s + 6], a0[8 * s + 7])};
        u32x4 w1 = {pk2(a1[8 * s + 0], a1[8 * s + 1]), pk2(a1[8 * s + 2], a1[8 * s + 3]), pk2(a1[8 * s + 4], a1[8 * s + 5]), pk2(a1[8 * s + 6], a1[8 * s + 7])};
        pa[0][s] = __builtin_bit_cast(bf16x8, w0); pa[1][s] = __builtin_bit_cast(bf16x8, w1);
    }
    __builtin_amdgcn_sched_barrier(0);
    if (!TWO) {
#pragma unroll
        for (int blk = 0; blk < 2; ++blk)
#pragma unroll
            for (int s = 0; s < 2; ++s) {
                o0 = __builtin_amdgcn_mfma_f32_32x32x16_bf16(vfa[blk][s], pa[blk][s], o0, 0, 0, 0);
                o1 = __builtin_amdgcn_mfma_f32_32x32x16_bf16(vfc[blk][s], pa[blk][s], o1, 0, 0, 0);
                osum = __builtin_amdgcn_mfma_f32_32x32x16_bf16(vones, pa[blk][s], osum, 0, 0, 0);
            }
    } else {
#pragma unroll
        for (int g = 0; g < 4; ++g) { const int blk = g >> 1, s = g & 1;
            o0 = __builtin_amdgcn_mfma_f32_32x32x16_bf16(vfa[blk][s], pa[blk][s], o0, 0, 0, 0);
#pragma unroll
            for (int r = 0; r < 4; ++r) b0[4 * g + r] = __builtin_amdgcn_exp2f(b0[4 * g + r]);
            __builtin_amdgcn_sched_barrier(0);
            o1 = __builtin_amdgcn_mfma_f32_32x32x16_bf16(vfc[blk][s], pa[blk][s], o1, 0, 0, 0);
#pragma unroll
            for (int r = 0; r < 4; ++r) b1[4 * g + r] = __builtin_amdgcn_exp2f(b1[4 * g + r]);
            __builtin_amdgcn_sched_barrier(0);
            osum = __builtin_amdgcn_mfma_f32_32x32x16_bf16(vones, pa[blk][s], osum, 0, 0, 0);
            __builtin_amdgcn_sched_barrier(0);
        }
        bf16x8 vga[2][2], vgc[2][2];
#pragma unroll
        for (int blk = 0; blk < 2; ++blk)
#pragma unroll
            for (int s = 0; s < 2; ++s) {
                LAS const unsigned char* vp = VbB + q32 * AL_V_STRIDE + (32 * blk + 16 * s + 4 * hi) * 2;
                const s16x4 x0 = *(LAS const s16x4*)(vp), x1 = *(LAS const s16x4*)(vp + 16);
                const s16x4 c0 = *(LAS const s16x4*)(vp + 32 * AL_V_STRIDE), c1 = *(LAS const s16x4*)(vp + 32 * AL_V_STRIDE + 16);
                vga[blk][s] = (bf16x8){x0[0], x0[1], x0[2], x0[3], x1[0], x1[1], x1[2], x1[3]};
                vgc[blk][s] = (bf16x8){c0[0], c0[1], c0[2], c0[3], c1[0], c1[1], c1[2], c1[3]};
            }
        bf16x8 pbb[2][2];
#pragma unroll
        for (int s = 0; s < 2; ++s) {
            u32x4 w0 = {pk2(b0[8 * s + 0], b0[8 * s + 1]), pk2(b0[8 * s + 2], b0[8 * s + 3]), pk2(b0[8 * s + 4], b0[8 * s + 5]), pk2(b0[8 * s + 6], b0[8 * s + 7])};
            u32x4 w1 = {pk2(b1[8 * s + 0], b1[8 * s + 1]), pk2(b1[8 * s + 2], b1[8 * s + 3]), pk2(b1[8 * s + 4], b1[8 * s + 5]), pk2(b1[8 * s + 6], b1[8 * s + 7])};
            pbb[0][s] = __builtin_bit_cast(bf16x8, w0); pbb[1][s] = __builtin_bit_cast(bf16x8, w1);
        }
        __builtin_amdgcn_sched_barrier(0);
#pragma unroll
        for (int blk = 0; blk < 2; ++blk)
#pragma unroll
            for (int s = 0; s < 2; ++s) {
                o0 = __builtin_amdgcn_mfma_f32_32x32x16_bf16(vga[blk][s], pbb[blk][s], o0, 0, 0, 0);
                o1 = __builtin_amdgcn_mfma_f32_32x32x16_bf16(vgc[blk][s], pbb[blk][s], o1, 0, 0, 0);
                osum = __builtin_amdgcn_mfma_f32_32x32x16_bf16(vones, pbb[blk][s], osum, 0, 0, 0);
            }
    }
}

__device__ __forceinline__ void moba_walk(LAS unsigned char* L, const int nt, const int q0, const int qpos, const int q32, const int hi, const int qb, const unsigned sel, const bf16x8 (&qf)[4],
                                          const bf16_t* ksrc, const bf16_t* vsrc, const int kwoff, const int vwoff, f32x16& negm, f32x16& o0, f32x16& o1, float& mref, f32x16& osum) {
    asm volatile("" : "+v"(ksrc), "+v"(vsrc));
    f32x16 cinp = negm; int cin_blk = -1;
    const int tw = (q0 + 31) >> 6;
#define ML_LOAD(tt) do { rk0 = *(const u32x4*)(ksrc + (size_t)(tt) * 4096); rv0 = *(const u32x4*)(vsrc + (size_t)(tt) * 4096); rk1 = *(const u32x4*)(ksrc + (size_t)((tt) - 1) * 4096); rv1 = *(const u32x4*)(vsrc + (size_t)((tt) - 1) * 4096); } while (0)
#define ML_STORE(tt) do { const int sa_ = (tt) & 3, sb_ = ((tt) - 1) & 3; \
        *(LAS u32x4*)(L + ML_K + sa_ * 8192 + kwoff) = rk0; *(LAS u32x2*)(L + ML_V + sa_ * AL_VB + vwoff) = (u32x2){rv0.x, rv0.y}; *(LAS u32x2*)(L + ML_V + sa_ * AL_VB + vwoff + 8) = (u32x2){rv0.z, rv0.w}; \
        *(LAS u32x4*)(L + ML_K + sb_ * 8192 + kwoff) = rk1; *(LAS u32x2*)(L + ML_V + sb_ * AL_VB + vwoff) = (u32x2){rv1.x, rv1.y}; *(LAS u32x2*)(L + ML_V + sb_ * AL_VB + vwoff + 8) = (u32x2){rv1.z, rv1.w}; } while (0)
    { u32x4 rk0, rv0, rk1, rv1; ML_LOAD(nt - 1); ML_STORE(nt - 1); }
    __syncthreads();
    for (int t = nt - 1; t > 0; t -= 2) {
        const bool more = (t >= 3);
        u32x4 rk0, rv0, rk1, rv1;
        ML_LOAD(more ? t - 2 : t);
        if (t - 1 <= tw) {
            const int nblk = t >> 2;
            if (cin_blk != nblk) { cin_blk = nblk; const bool unsel = (nblk < qb) && !((sel >> nblk) & 1u);
#pragma unroll
                for (int r = 0; r < 16; ++r) cinp[r] = unsel ? -INFINITY : negm[r]; }
            LAS const unsigned char* KA = L + ML_K + (t & 3) * 8192; LAS const unsigned char* VA = L + ML_V + (t & 3) * AL_VB;
            LAS const unsigned char* KB = L + ML_K + ((t - 1) & 3) * 8192; LAS const unsigned char* VB = L + ML_V + ((t - 1) & 3) * AL_VB;
            moba_step(KA, VA, KB, VB, t >= tw, t - 1 == tw, t * 64, qpos, q32, hi, qf, cinp, negm, o0, o1, mref, osum, cin_blk);
        }
        if (!more) break;
        ML_STORE(t - 2);
        __syncthreads();
    }
#undef ML_LOAD
#undef ML_STORE
}

__device__ __forceinline__ void moba_gather_item(const Ctx& C, const Args& a, const int l, const int c, const int len) {
    const int tid = opaque_tid(C), lane = tid & 63, wid = C.wave, q32 = lane & 31, hi = lane >> 5;
    unsigned char* ws = a.ws; unsigned char* xs = (unsigned char*)a.out;
    const int bh = l >> 4, j = l & 15;
    const bf16_t* Q = (const bf16_t*)(ws + WS_QM);
    const bf16_t* K = (const bf16_t*)(ws + WS_KM);
    const bf16_t* VT = (const bf16_t*)(ws + WS_VT) + (size_t)(64 + bh) * 64 * SEQ;
    LAS unsigned char* L = C.lds;
    { const int lrow = tid >> 3, lch = tid & 7;
      const bf16_t* ksrc = K + ((size_t)bh * SEQ + lrow) * 64 + lch * 8 + (size_t)(4 * j) * 4096;
      const bf16_t* vsrc = VT + (size_t)lrow * 64 + lch * 8 + (size_t)(4 * j) * 4096;
      const int kwoff = lrow * 128 + ((lch ^ ((lrow >> 1) & 7)) * 16), vwoff = lrow * AL_V_STRIDE + lch * 16;
      u32x4 rk[4], rv[4];
#pragma unroll
      for (int i = 0; i < 4; ++i) { rk[i] = *(const u32x4*)(ksrc + (size_t)i * 4096); rv[i] = *(const u32x4*)(vsrc + (size_t)i * 4096); }
#pragma unroll
      for (int i = 0; i < 4; ++i) { *(LAS u32x4*)(L + ML_K + i * 8192 + kwoff) = rk[i];
          *(LAS u32x2*)(L + ML_V + i * AL_VB + vwoff) = (u32x2){rv[i].x, rv[i].y}; *(LAS u32x2*)(L + ML_V + i * AL_VB + vwoff + 8) = (u32x2){rv[i].z, rv[i].w}; } }
    const int n = min(GCHUNK, len - c * GCHUNK);
    const unsigned short* LIST = (const unsigned short*)(xs + XS_LIST) + (size_t)l * LIST_CAP + c * GCHUNK;
    unsigned e1, e2;
#define LIST_LD(ix) ({ const int ix_ = (ix); const unsigned w_ = __hip_atomic_load((const unsigned*)LIST + (ix_ >> 1), __ATOMIC_RELAXED, __HIP_MEMORY_SCOPE_AGENT); (ix_ & 1) ? (w_ >> 16) : (w_ & 0xffffu); })
    { const int i0 = 32 * wid + q32, i1 = 256 + 32 * wid + q32; e1 = LIST_LD(i0 < n ? i0 : 0); e2 = LIST_LD(i1 < n ? i1 : 0); }
    bf16x8 qn[4];
    { const bf16_t* qp = Q + ((size_t)bh * SEQ + (e1 & 4095)) * 64 + hi * 8;
#pragma unroll
      for (int ks = 0; ks < 4; ++ks) qn[ks] = *(const bf16x8*)(qp + ks * 16); }
    __syncthreads();
    for (int sc = 0; sc < GCHUNK / 256; ++sc) {
        const int idx = sc * 256 + 32 * wid + q32;
        if (sc * 256 + 32 * wid >= n) break;
        const bool valid = idx < n;
        const unsigned e = e1;
        const int qpos = e & 4095, r = e >> 12;
        bf16x8 qf[4];
#pragma unroll
        for (int ks = 0; ks < 4; ++ks) qf[ks] = qn[ks];
        e1 = e2;
        { const int i2 = idx + 512; e2 = LIST_LD(i2 < n ? i2 : 0); }
        { const bf16_t* qp = Q + ((size_t)bh * SEQ + (e1 & 4095)) * 64 + hi * 8;
#pragma unroll
          for (int ks = 0; ks < 4; ++ks) qn[ks] = *(const bf16x8*)(qp + ks * 16); }
        float mref;
        { float s_ = 0.f;
#pragma unroll
          for (int ks = 0; ks < 4; ++ks) { const bf16x8 kk = *(LAS const bf16x8*)(L + ML_K + (2 * ks + hi) * 16);
#pragma unroll
              for (int jj = 0; jj < 8; ++jj) s_ += bf2f(qf[ks][jj]) * bf2f(kk[jj]); }
          mref = xhalf_sum(s_); }
        f32x16 osum = {0.f, 0.f, 0.f, 0.f, 0.f, 0.f, 0.f, 0.f, 0.f, 0.f, 0.f, 0.f, 0.f, 0.f, 0.f, 0.f}, o0 = osum, o1 = osum;
        f32x16 negm;
#pragma unroll
        for (int i = 0; i < 16; ++i) negm[i] = -mref;
        int cin_blk = 0;
        for (int p = 0; p < 2; ++p) {
            const int ta = 3 - 2 * p, tb = 2 - 2 * p;
            moba_step(L + ML_K + ta * 8192, L + ML_V + ta * AL_VB, L + ML_K + tb * 8192, L + ML_V + tb * AL_VB, false, false, 0, 0, q32, hi, qf, negm, negm, o0, o1, mref, osum, cin_blk);
        }
        const float ltot = xhalf_lo(osum[0]);
        if (valid) {
            const size_t slot = ((size_t)bh * SEQ + qpos) * 3 + r;
            bf16_t* P = (bf16_t*)(xs + XS_PART) + slot * 64 + 32 * hi;
#pragma unroll
            for (int g = 0; g < 2; ++g) {
                const u32x4 w0 = {pk2(o0[8 * g], o0[8 * g + 1]), pk2(o0[8 * g + 2], o0[8 * g + 3]), pk2(o0[8 * g + 4], o0[8 * g + 5]), pk2(o0[8 * g + 6], o0[8 * g + 7])};
                const u32x4 w1 = {pk2(o1[8 * g], o1[8 * g + 1]), pk2(o1[8 * g + 2], o1[8 * g + 3]), pk2(o1[8 * g + 4], o1[8 * g + 5]), pk2(o1[8 * g + 6], o1[8 * g + 7])};
                asm volatile("global_store_dwordx4 %0, %1, off sc1\n\ts_nop 1" :: "v"(P + 8 * g), "v"(w0) : "memory");
                asm volatile("global_store_dwordx4 %0, %1, off sc1\n\ts_nop 1" :: "v"(P + 16 + 8 * g), "v"(w1) : "memory");
            }
            if (hi == 0) { const f32x2 mlv = {mref, ltot}; asm volatile("global_store_dwordx2 %0, %1, off sc1\n\ts_nop 1" :: "v"((float*)(xs + XS_ML) + slot * 2), "v"(mlv) : "memory"); }
        }
    }
    asm volatile("s_waitcnt vmcnt(0)" ::: "memory");
    __syncthreads();
    if (tid == 0) __hip_atomic_fetch_add((unsigned*)(ws + WS_CTL) + CW_GDONE + 32 * bh, 1u, __ATOMIC_RELAXED, __HIP_MEMORY_SCOPE_AGENT);
}

__device__ __forceinline__ void moba_own_item(const Ctx& C, const Args& a, const int bh, const int qb) {
    const int tid = opaque_tid(C), lane = tid & 63, wid = C.wave, q32 = lane & 31, hi = lane >> 5;
    unsigned char* ws = a.ws; const unsigned char* xs = (const unsigned char*)a.out;
    const int b = bh >> 3, h = bh & 7;
    const bf16_t* Q = (const bf16_t*)(ws + WS_QM);
    const bf16_t* K = (const bf16_t*)(ws + WS_KM);
    const bf16_t* VT = (const bf16_t*)(ws + WS_VT) + (size_t)(64 + bh) * 64 * SEQ;
    LAS unsigned char* L = C.lds;
    const int qrel = 32 * wid + q32, qpos = qb * 256 + qrel;
    { const int lrow = tid >> 3, lch = tid & 7;
      const bf16_t* ksrc = K + ((size_t)bh * SEQ + lrow) * 64 + lch * 8 + (size_t)(4 * qb) * 4096;
      const bf16_t* vsrc = VT + (size_t)lrow * 64 + lch * 8 + (size_t)(4 * qb) * 4096;
      const int kwoff = lrow * 128 + ((lch ^ ((lrow >> 1) & 7)) * 16), vwoff = lrow * AL_V_STRIDE + lch * 16;
      u32x4 rk[4], rv[4];
#pragma unroll
      for (int i = 0; i < 4; ++i) { rk[i] = *(const u32x4*)(ksrc + (size_t)i * 4096); rv[i] = *(const u32x4*)(vsrc + (size_t)i * 4096); }
#pragma unroll
      for (int i = 0; i < 4; ++i) { *(LAS u32x4*)(L + ML_K + i * 8192 + kwoff) = rk[i];
          *(LAS u32x2*)(L + ML_V + i * AL_VB + vwoff) = (u32x2){rv[i].x, rv[i].y}; *(LAS u32x2*)(L + ML_V + i * AL_VB + vwoff + 8) = (u32x2){rv[i].z, rv[i].w}; } }
    bf16x8 qf[4];
    { const bf16_t* qp = Q + ((size_t)bh * SEQ + qpos) * 64 + hi * 8;
#pragma unroll
      for (int ks = 0; ks < 4; ++ks) qf[ks] = *(const bf16x8*)(qp + ks * 16); }
    const int ns = qb < 3 ? qb : 3; const size_t slot0 = ((size_t)bh * SEQ + qpos) * 3;
    f32x2 ml[3];
#pragma unroll
    for (int r = 0; r < 3; ++r) { ml[r] = (f32x2){0.f, 0.f};
        if (r < ns) { const unsigned long long v_ = __hip_atomic_load((const unsigned long long*)((const float*)(xs + XS_ML) + (slot0 + r) * 2), __ATOMIC_RELAXED, __HIP_MEMORY_SCOPE_AGENT);
            ml[r] = (f32x2){__uint_as_float((unsigned)v_), __uint_as_float((unsigned)(v_ >> 32))}; } }
    __syncthreads();
    float mref;
    { const int kr = qrel & 63; LAS const unsigned char* Kr = L + ML_K + (qrel >> 6) * 8192 + kr * 128; const int ksw_ = (kr >> 1) & 7; float s_ = 0.f;
#pragma unroll
      for (int ks = 0; ks < 4; ++ks) { const bf16x8 kk = *(LAS const bf16x8*)(Kr + (((2 * ks + hi) ^ ksw_) * 16));
#pragma unroll
          for (int jj = 0; jj < 8; ++jj) s_ += bf2f(qf[ks][jj]) * bf2f(kk[jj]); }
      mref = xhalf_sum(s_); }
    f32x16 osum = {0.f, 0.f, 0.f, 0.f, 0.f, 0.f, 0.f, 0.f, 0.f, 0.f, 0.f, 0.f, 0.f, 0.f, 0.f, 0.f}, o0 = osum, o1 = osum;
    f32x16 negm;
#pragma unroll
    for (int i = 0; i < 16; ++i) negm[i] = -mref;
    const int tw = (32 * wid + 31) >> 6;
    int cin_blk = 0;
    for (int p = (tw >= 2 ? 0 : 1); p < 2; ++p) {
        const int ta = 3 - 2 * p, tb = 2 - 2 * p;
        moba_step(L + ML_K + ta * 8192, L + ML_V + ta * AL_VB, L + ML_K + tb * 8192, L + ML_V + tb * AL_VB, ta >= tw, tb == tw, ta * 64, qrel, q32, hi, qf, negm, negm, o0, o1, mref, osum, cin_blk);
    }
    float ltot = xhalf_lo(osum[0]);
    if (qb > 0) {
        u32x4 pv[3][4];
#pragma unroll
        for (int r = 0; r < 3; ++r) if (r < ns) { const bf16_t* P = (const bf16_t*)(xs + XS_PART) + (slot0 + r) * 64 + 32 * hi;
#pragma unroll
            for (int g = 0; g < 2; ++g) { pv[r][g] = *(const u32x4*)(P + 8 * g); pv[r][2 + g] = *(const u32x4*)(P + 16 + 8 * g); } }
        float M = mref;
#pragma unroll
        for (int r = 0; r < 3; ++r) if (r < ns) M = __builtin_fmaxf(M, ml[r].x);
        const float so = __builtin_amdgcn_exp2f(mref - M);
        ltot *= so;
#pragma unroll
        for (int i = 0; i < 16; ++i) { o0[i] *= so; o1[i] *= so; }
#pragma unroll
        for (int r = 0; r < 3; ++r) if (r < ns) { const float sr = __builtin_amdgcn_exp2f(ml[r].x - M); ltot += sr * ml[r].y;
#pragma unroll
            for (int g = 0; g < 2; ++g) { const u32x4 u0 = pv[r][g], u1 = pv[r][2 + g];
                o0[8 * g] += sr * bflo(u0.x); o0[8 * g + 1] += sr * bfhi(u0.x); o0[8 * g + 2] += sr * bflo(u0.y); o0[8 * g + 3] += sr * bfhi(u0.y);
                o0[8 * g + 4] += sr * bflo(u0.z); o0[8 * g + 5] += sr * bfhi(u0.z); o0[8 * g + 6] += sr * bflo(u0.w); o0[8 * g + 7] += sr * bfhi(u0.w);
                o1[8 * g] += sr * bflo(u1.x); o1[8 * g + 1] += sr * bfhi(u1.x); o1[8 * g + 2] += sr * bflo(u1.y); o1[8 * g + 3] += sr * bfhi(u1.y);
                o1[8 * g + 4] += sr * bflo(u1.z); o1[8 * g + 5] += sr * bfhi(u1.z); o1[8 * g + 6] += sr * bflo(u1.w); o1[8 * g + 7] += sr * bfhi(u1.w); } }
    }
    const float rl = 1.0f / ltot;
    bf16_t* Y = (bf16_t*)(ws + WS_HB) + (size_t)T * AW + ((size_t)b * SEQ + qpos) * AW + h * 64 + 4 * hi;
#pragma unroll
    for (int g = 0; g < 4; ++g) {
        *(u32x2*)(Y + 8 * g) = (u32x2){pk2(o0[4 * g] * rl, o0[4 * g + 1] * rl), pk2(o0[4 * g + 2] * rl, o0[4 * g + 3] * rl)};
        *(u32x2*)(Y + 32 + 8 * g) = (u32x2){pk2(o1[4 * g] * rl, o1[4 * g + 1] * rl), pk2(o1[4 * g + 2] * rl, o1[4 * g + 3] * rl)};
    }
    __syncthreads();
}

__device__ __forceinline__ void attn_unit(const Ctx& C, const Args& a, int type, int bh, int qb) {
    const int tid_ = opaque_tid(C), lane_ = tid_ & 63;
    unsigned char* ws = a.ws;
    const int tid = tid_, lane = lane_, wid = C.wave, q32 = lane & 31, hi = lane >> 5;
    const int b = bh >> 3, h = bh & 7;
    const bf16_t* Q = (const bf16_t*)(ws + (type ? WS_QM : WS_QF));
    const bf16_t* K = (const bf16_t*)(ws + (type ? WS_KM : WS_KF));
    const bf16_t* VT = (const bf16_t*)(ws + WS_VT) + (size_t)(type * 64 + bh) * 64 * SEQ;
    const float* C2 = (const float*)(ws + WS_C2) + (size_t)bh * SEQ;
    const size_t rowbase = (size_t)b * SEQ;
    const int q0 = qb * 256 + wid * 32, qpos = q0 + q32;
    bf16x8 qf[4];
    { const bf16_t* qp = Q + ((size_t)bh * SEQ + qpos) * 64 + hi * 8;
#pragma unroll
      for (int ks = 0; ks < 4; ++ks) qf[ks] = *(const bf16x8*)(qp + ks * 16); }
    const unsigned sel = 0u;
    const float cq = (type == 0) ? C2[qpos] : 0.f;
    const int nt = (type == 0) ? 4 * (qb + 1) : 4;
    float qkb = 0.f;
    if (type == 0) {
        float qs = 0.f;
#pragma unroll
        for (int ks = 0; ks < 4; ++ks)
#pragma unroll
            for (int j = 0; j < 8; ++j) { const float v = bf2f(qf[ks][j]); qs += v * v; }
        qs = xhalf_sum(qs);
        const unsigned* KMX = (const unsigned*)(ws + WS_CTL) + CW_KMAX + 64 * (bh * 2);
        const float kmx = __uint_as_float(__hip_atomic_load(KMX, __ATOMIC_RELAXED, __HIP_MEMORY_SCOPE_AGENT)) + __uint_as_float(__hip_atomic_load(KMX + 64, __ATOMIC_RELAXED, __HIP_MEMORY_SCOPE_AGENT));
        qkb = sqrtf(qs * kmx) * 1.02f + cq;
    }
    const int lrow = tid >> 3, lch = tid & 7;
    const bf16_t* ksrc = K + ((size_t)bh * SEQ + lrow) * 64 + lch * 8;
    const bf16_t* vsrc = VT + (size_t)lrow * 64 + lch * 8;
    const int kwoff = lrow * 128 + ((lch ^ ((lrow >> 1) & 7)) * 16);
    const int vwoff = lrow * AL_V_STRIDE + lch * 16;
    LAS unsigned char* L = C.lds;
    float mref;
    { const bf16_t* kp = K + ((size_t)bh * SEQ + qpos) * 64 + hi * 8; float s_ = 0.f;
#pragma unroll
      for (int ks = 0; ks < 4; ++ks) { const bf16x8 kk = *(const bf16x8*)(kp + ks * 16);
#pragma unroll
          for (int j = 0; j < 8; ++j) s_ += bf2f(qf[ks][j]) * bf2f(kk[j]); }
      mref = xhalf_sum(s_); }
    f32x16 osum = {0.f, 0.f, 0.f, 0.f, 0.f, 0.f, 0.f, 0.f, 0.f, 0.f, 0.f, 0.f, 0.f, 0.f, 0.f, 0.f};
    const float base = cq;
    f32x16 negm;
#pragma unroll
    for (int r = 0; r < 16; ++r) negm[r] = base - mref;
    f32x16 o0 = {0.f, 0.f, 0.f, 0.f, 0.f, 0.f, 0.f, 0.f, 0.f, 0.f, 0.f, 0.f, 0.f, 0.f, 0.f, 0.f}, o1 = o0;
    if (type == 0) {
        volatile LAS unsigned* VOTE = (volatile LAS unsigned*)(L + AL_VOTE);
        u32x4 rk, rv; float rc = 0.f;
        { const int kvs = (nt - 1) * 64;
          rk = *(const u32x4*)(ksrc + (size_t)(nt - 1) * 4096); rv = *(const u32x4*)(vsrc + (size_t)(nt - 1) * 4096); if (tid < 64) rc = C2[kvs + tid]; }
        { const int bsel = (nt - 1) & 1, vsel = (nt - 1) % 3;
          *(LAS u32x4*)(L + AL_K + bsel * 8192 + kwoff) = rk; *(LAS u32x2*)(L + AL_V + vsel * AL_VB + vwoff) = (u32x2){rv.x, rv.y}; *(LAS u32x2*)(L + AL_V + vsel * AL_VB + vwoff + 8) = (u32x2){rv.z, rv.w};
          if (tid < 64) *(LAS float*)(L + AL_C + bsel * 256 + tid * 4) = rc; }
        __syncthreads();
        attn_loop<false, 0>(L, VOTE, nt, tid, lane, wid, q0, qpos, q32, hi, qb, sel, base, qkb, qf, ksrc, vsrc, C2, kwoff, vwoff, rk, rv, rc, negm, o0, o1, mref, osum);
    } else moba_walk(L, 4, wid * 32, wid * 32 + q32, q32, hi, 0, 0u, qf, ksrc + (size_t)(4 * qb) * 4096, vsrc + (size_t)(4 * qb) * 4096, kwoff, vwoff, negm, o0, o1, mref, osum);
    __syncthreads();
    float ltot = xhalf_lo(osum[0]);
    if (type == 1 && qb > 0) {
        const unsigned char* xs = (const unsigned char*)a.out;
        const int ns = qb < 3 ? qb : 3; const size_t slot0 = ((size_t)bh * SEQ + qpos) * 3;
        f32x2 ml[3]; u32x4 pv[3][4];
#pragma unroll
        for (int r = 0; r < 3; ++r) if (r < ns) { ml[r] = *(const f32x2*)((const float*)(xs + XS_ML) + (slot0 + r) * 2);
            const bf16_t* P = (const bf16_t*)(xs + XS_PART) + (slot0 + r) * 64 + 32 * hi;
#pragma unroll
            for (int g = 0; g < 2; ++g) { pv[r][g] = *(const u32x4*)(P + 8 * g); pv[r][2 + g] = *(const u32x4*)(P + 16 + 8 * g); } }
        float M = mref;
#pragma unroll
        for (int r = 0; r < 3; ++r) if (r < ns) M = __builtin_fmaxf(M, ml[r].x);
        const float so = __builtin_amdgcn_exp2f(mref - M);
        ltot *= so;
#pragma unroll
        for (int i = 0; i < 16; ++i) { o0[i] *= so; o1[i] *= so; }
#pragma unroll
        for (int r = 0; r < 3; ++r) if (r < ns) { const float sr = __builtin_amdgcn_exp2f(ml[r].x - M); ltot += sr * ml[r].y;
#pragma unroll
            for (int g = 0; g < 2; ++g) { const u32x4 u0 = pv[r][g], u1 = pv[r][2 + g];
                o0[8 * g] += sr * bflo(u0.x); o0[8 * g + 1] += sr * bfhi(u0.x); o0[8 * g + 2] += sr * bflo(u0.y); o0[8 * g + 3] += sr * bfhi(u0.y);
                o0[8 * g + 4] += sr * bflo(u0.z); o0[8 * g + 5] += sr * bfhi(u0.z); o0[8 * g + 6] += sr * bflo(u0.w); o0[8 * g + 7] += sr * bfhi(u0.w);
                o1[8 * g] += sr * bflo(u1.x); o1[8 * g + 1] += sr * bfhi(u1.x); o1[8 * g + 2] += sr * bflo(u1.y); o1[8 * g + 3] += sr * bfhi(u1.y);
                o1[8 * g + 4] += sr * bflo(u1.z); o1[8 * g + 5] += sr * bfhi(u1.z); o1[8 * g + 6] += sr * bflo(u1.w); o1[8 * g + 7] += sr * bfhi(u1.w); } }
    }
    const float rl = 1.0f / ltot;
    bf16_t* Y = (bf16_t*)(ws + WS_HB) + (size_t)type * T * AW + (rowbase + qpos) * AW + h * 64 + 4 * hi;
#pragma unroll
    for (int g = 0; g < 4; ++g) {
        *(u32x2*)(Y + 8 * g) = (u32x2){pk2(o0[4 * g] * rl, o0[4 * g + 1] * rl), pk2(o0[4 * g + 2] * rl, o0[4 * g + 3] * rl)};
        *(u32x2*)(Y + 32 + 8 * g) = (u32x2){pk2(o1[4 * g] * rl, o1[4 * g + 1] * rl), pk2(o1[4 * g + 2] * rl, o1[4 * g + 3] * rl)};
    }
}


struct P4Sched {
    const char* A; const char* B; int vcu, G;
    __device__ __forceinline__ bool next(int i, pg8::GUnit& u) const {
        const int L = i * G + vcu; if (L >= 512) return false;
        const int pm = L >> 2, pn = L & 3; u.x0 = pm; u.x1 = pn; u.x2 = 0; u.x3 = 0;
        u.a0 = A + (size_t)pm * 256 * 2048; u.a1 = u.a0 + (size_t)128 * 2048; u.b0 = B + (size_t)pn * 256 * 2048; u.b1 = u.b0 + (size_t)128 * 2048; return true; }
};
struct P4Epi {
    const float* x; bf16_t* xb;
    __device__ __forceinline__ void operator()(Acc& acc, const pg8::GUnit& u, int wr, int wc, int fr, int fq) const {
        const int cb = u.x1 * 256 + 32 * wc + 8 * fq;
#pragma unroll
        for (int ai = 0; ai < 2; ++ai)
#pragma unroll
            for (int mh = 0; mh < 2; ++mh) {
                f32x4 xv[2][2][2];
#pragma unroll
                for (int m2 = 0; m2 < 2; ++m2) { const size_t ro = (size_t)(u.x0 * 256 + 128 * ai + 64 * wr + RL(2 * mh + m2, fr)) * DM + cb;
#pragma unroll
                    for (int bj = 0; bj < 2; ++bj)
#pragma unroll
                        for (int n = 0; n < 2; ++n) xv[m2][bj][n] = *(const f32x4*)(x + ro + 128 * bj + 4 * n); }
#pragma unroll
                for (int m2 = 0; m2 < 2; ++m2) { const int m = 2 * mh + m2; const size_t ro = (size_t)(u.x0 * 256 + 128 * ai + 64 * wr + RL(m, fr)) * DM + cb;
#pragma unroll
                    for (int bj = 0; bj < 2; ++bj)
#pragma unroll
                        for (int n = 0; n < 2; ++n) { const f32x4 v = xv[m2][bj][n] + acc[ai][bj][m][n]; *(u32x2*)(xb + ro + 128 * bj + 4 * n) = (u32x2){pk2(v.x, v.y), pk2(v.z, v.w)}; } }
                EPI_FENCE(); }
    }
};

template <bool FINAL>
__device__ __forceinline__ void p5_wave(const Ctx& C, const Args& a, int task) {
    const int tid_ = opaque_tid(C), lane = tid_ & 63, fr = lane & 15, fq = lane >> 4;
    unsigned char* ws = a.ws;
    const int tok0 = task * 16;
    const bf16_t* xr = (const bf16_t*)(ws + WS_X1) + (size_t)(tok0 + fr) * DM + 8 * fq;
    const u32x4* WH = (const u32x4*)(ws + WS_WRH) + lane; const u32x4* WL = (const u32x4*)(ws + WS_WRL) + lane;
    f32x4 acc[3] = {{0.f, 0.f, 0.f, 0.f}, {0.f, 0.f, 0.f, 0.f}, {0.f, 0.f, 0.f, 0.f}};
    float ss = 0.f;
#pragma unroll 4
    for (int ks = 0; ks < 32; ++ks) {
        const u32x4 hw = *(const u32x4*)(xr + 32 * ks);
        { const float a0 = bflo(hw.x), a1 = bfhi(hw.x), a2 = bflo(hw.y), a3 = bfhi(hw.y), a4 = bflo(hw.z), a5 = bfhi(hw.z), a6 = bflo(hw.w), a7 = bfhi(hw.w);
          ss += (a0 * a0 + a1 * a1) + (a2 * a2 + a3 * a3) + (a4 * a4 + a5 * a5) + (a6 * a6 + a7 * a7); }
        const bf16x8 ah = __builtin_bit_cast(bf16x8, hw);
#pragma unroll
        for (int nf = 0; nf < 3; ++nf) {
            const bf16x8 bh = __builtin_bit_cast(bf16x8, WH[(ks * 3 + nf) * 64]), bl = __builtin_bit_cast(bf16x8, WL[(ks * 3 + nf) * 64]);
            acc[nf] = __builtin_amdgcn_mfma_f32_16x16x32_bf16(bh, ah, acc[nf], 0, 0, 0);
            acc[nf] = __builtin_amdgcn_mfma_f32_16x16x32_bf16(bl, ah, acc[nf], 0, 0, 0);
        }
    }
    ss += __shfl_xor(ss, 16); ss += __shfl_xor(ss, 32);
    const float rstd = 1.0f / sqrtf(ss * (1.0f / DM) + RMS_EPS);
    LAS float* sc = (LAS float*)(C.lds + C.wave * 3072);
#pragma unroll
    for (int nf = 0; nf < 3; ++nf) *(LAS f32x4*)(sc + fr * 48 + 16 * nf + 4 * fq) = acc[nf] * rstd;
    asm volatile("s_waitcnt lgkmcnt(0)" ::: "memory");
    int ea = -1, eb = -1; const int tok = tok0 + lane;
    if (lane < 16) {
        float lg[36];
#pragma unroll
        for (int c4 = 0; c4 < 9; ++c4) { const f32x4 v = *(LAS const f32x4*)(sc + lane * 48 + 4 * c4); lg[4 * c4] = v.x; lg[4 * c4 + 1] = v.y; lg[4 * c4 + 2] = v.z; lg[4 * c4 + 3] = v.w; }
        ((float*)(ws + WS_RSTD2))[tok] = rstd;
        float g4[4];
#pragma unroll
        for (int c = 0; c < 4; ++c) g4[c] = lg[c] + a.in[10][c];
        int gi = 0; float gm = g4[0];
#pragma unroll
        for (int c = 1; c < 4; ++c) if (g4[c] > gm) { gm = g4[c]; gi = c; }
        float gs = 0.f;
#pragma unroll
        for (int c = 0; c < 4; ++c) gs += __expf(g4[c] - gm);
        const float gtop = 1.0f / gs;
        float lf[8];
#pragma unroll
        for (int j = 0; j < 8; ++j) { const float v0 = lg[4 + j], v1 = lg[12 + j], v2 = lg[20 + j], v3 = lg[28 + j];
            const float v = (gi == 0) ? v0 : (gi == 1) ? v1 : (gi == 2) ? v2 : v3; lf[j] = v + a.in[12][gi * 8 + j]; }
        int i1 = 0, i2 = 0; float f1 = -INFINITY, f2 = -INFINITY;
#pragma unroll
        for (int j = 0; j < 8; ++j) { if (lf[j] > f1) { f2 = f1; i2 = i1; f1 = lf[j]; i1 = j; } else if (lf[j] > f2) { f2 = lf[j]; i2 = j; } }
        const float e2 = __expf(f2 - f1), den = 1.0f / (1.0f + e2);
        float* TW = (float*)(ws + WS_TOKW);
        TW[tok * 2] = gtop * den; TW[tok * 2 + 1] = gtop * e2 * den;
        ea = gi * 8 + i1; eb = gi * 8 + i2;
    }
    if (FINAL) {
        unsigned* CNT = (unsigned*)(ws + WS_CTL) + CW_CNT; int* LISTS = (int*)(ws + WS_LISTS);
        unsigned mym1 = 0u, mym2 = 0u;
        for (int e = 0; e < NE; ++e) { const unsigned m1 = (unsigned)__ballot(ea == e), m2 = (unsigned)__ballot(eb == e); if (lane == e) { mym1 = m1; mym2 = m2; } }
        const int n1 = __popc(mym1), n2 = __popc(mym2);
        unsigned base = 0u;
        if (lane < NE && n1 + n2 > 0) base = __hip_atomic_fetch_add(CNT + 64 * lane, (unsigned)(n1 + n2), __ATOMIC_RELAXED, __HIP_MEMORY_SCOPE_AGENT);
        const int sa = (ea < 0) ? 0 : ea, sb = (eb < 0) ? 0 : eb;
        const unsigned ba = __shfl(base, sa), ma1 = __shfl(mym1, sa);
        const unsigned bb = __shfl(base, sb), mb1 = __shfl(mym1, sb), mb2 = __shfl(mym2, sb);
        const unsigned ltm = (1u << (lane & 31)) - 1u;
        if (ea >= 0) {
            LISTS[(size_t)ea * T + ba + __popc(ma1 & ltm)] = tok * 2;
            LISTS[(size_t)eb * T + bb + __popc(mb1) + __popc(mb2 & ltm)] = tok * 2 + 1;
        }
    }
}

__device__ __forceinline__ int moe_tiles(const Ctx& C, const Args& a, LAS int* tst) {
    const int tid_ = opaque_tid(C);
    if (tid_ < 64) {
        const unsigned* CNT = (const unsigned*)(a.ws + WS_CTL) + CW_CNT;
        const int c = (tid_ < NE) ? (int)__hip_atomic_load(CNT + 64 * tid_, __ATOMIC_RELAXED, __HIP_MEMORY_SCOPE_AGENT) : 0;
        const int nt_ = (c + 255) >> 8; int inc = nt_;
#pragma unroll
        for (int o = 1; o < 32; o <<= 1) { const int nb = __shfl_up(inc, o); if (tid_ >= o) inc += nb; }
        if (tid_ < NE) { tst[tid_] = inc - nt_; tst[33 + tid_] = c; }
        if (tid_ == NE - 1) tst[32] = inc;
    }
    __syncthreads();
    return tst[32];
}


constexpr int UD_OFF = MISC_OFF + 1024, UL_OFF = MISC_OFF + 2048;
__device__ __forceinline__ int moe_down_unit(int nun, int v, int G, int i, int& n7) {
    const int U = nun / G, r = nun - U * G, cap = (3 * nun + G - 1) / G;
    const int capv = cap - 2 * (U + (v < r ? 1 : 0)), s0 = v * (cap - 1) - 2 * (v * U + min(v, r));
    const int c = max(0, min(min(capv - 1, 7), (nun - G) - s0));
    n7 = (v < nun) ? 1 + c : 0;
    return i == 0 ? v : nun - s0 - c + (i - 1);
}
__device__ __forceinline__ int moe_prepare(const Ctx& C, const Args& a, LAS int* tst) {
    const int tid_ = opaque_tid(C);
    const int ntile = moe_tiles(C, a, tst);
    LAS int* UD = (LAS int*)(C.lds + UD_OFF); LAS int* UL = (LAS int*)(C.lds + UL_OFF);
    const int nun = ntile * 4;
    if (tid_ < 16) {
        const int i = tid_ & 7, dn = tid_ >> 3;
        int n7; const int du = moe_down_unit(nun, C.vcu, C.G, i, n7);
        const int u = dn ? (i < n7 ? du : nun) : i * C.G + C.vcu;
        if (u < nun) {
            const int gt = u >> 2; int e = 0;
            for (int j = 1; j < NE; ++j) if (tst[j] <= gt) e = j;
            const int rt = gt - tst[e], nvalid = tst[33 + e] - rt * 256;
            LAS int* d = UD + dn * 64 + i * 8;
            d[0] = e; d[1] = gt; d[2] = u & 3; d[3] = nvalid; d[4] = rt;
        }
    }
    __syncthreads();
    {
        const int i = tid_ >> 6, l = tid_ & 63;
        if (i * C.G + C.vcu < nun) {
            const int e = UD[i * 8 + 0], nvalid = UD[i * 8 + 3], rt = UD[i * 8 + 4];
            const int* LIST = (const int*)(a.ws + WS_LISTS) + (size_t)e * T + rt * 256;
            int v[4];
#pragma unroll
            for (int k = 0; k < 4; ++k) v[k] = (l + 64 * k < nvalid) ? LIST[l + 64 * k] : -1;
#pragma unroll
            for (int k = 0; k < 4; ++k) UL[i * 256 + l + 64 * k] = v[k];
        }
    }
    __syncthreads();
    return nun;
}


struct MoeSched {
    const char* XB; const char* WG; const char* WU; const char* HB_; const char* WD; LAS const int* UD; LAS const int* UL; unsigned* ctl; int n6, n7;
    __device__ __forceinline__ bool next(int i, pg8::SUnit& u) const {
        if (i < 2 * n6) { const int it = i >> 1, half = i & 1;
            const int e = __builtin_amdgcn_readfirstlane(UD[it * 8 + 0]), gt = __builtin_amdgcn_readfirstlane(UD[it * 8 + 1]), pn4 = __builtin_amdgcn_readfirstlane(UD[it * 8 + 2]);
            u.x0 = it; u.x1 = pn4; u.x2 = gt; u.x3 = 0; u.a0 = XB + half * 1024; u.a1 = u.a0;
            u.b0 = WG + ((size_t)e * DE + pn4 * 128) * 2048 + half * 1024; u.b1 = WU + ((size_t)e * DE + pn4 * 128) * 2048 + half * 1024;
            u.flags = pg8::SF_PITCH1 | pg8::SF_GATHER | (half == 0 ? pg8::SF_CHAIN : pg8::SF_PUBLISH); return true; }
        if (i < 2 * n6 + n7) { const int it = i - 2 * n6;
            const int e = __builtin_amdgcn_readfirstlane(UD[64 + it * 8 + 0]), gt = __builtin_amdgcn_readfirstlane(UD[64 + it * 8 + 1]), pn = __builtin_amdgcn_readfirstlane(UD[64 + it * 8 + 2]);
            u.x0 = it; u.x1 = pn; u.x2 = gt; u.x3 = 1; u.a0 = HB_ + (size_t)gt * 256 * 1024; u.a1 = u.a0 + (size_t)128 * 1024;
            u.b0 = WD + ((size_t)e * DM + pn * 256) * 1024; u.b1 = u.b0 + (size_t)128 * 1024; u.flags = pg8::SF_WAIT; return true; }
        return false; }
    __device__ __forceinline__ void avoff(const pg8::SUnit& u, const int (&RR)[2], const int (&CC)[2], unsigned (&v0)[2], unsigned (&v1)[2]) const {
#pragma unroll
        for (int i = 0; i < 2; ++i) { const int e0 = UL[u.x0 * 256 + RR[i]], e1 = UL[u.x0 * 256 + 128 + RR[i]];
            v0[i] = (unsigned)((e0 < 0 ? 0 : (e0 >> 1)) * 2048 + CC[i] * 2); v1[i] = (unsigned)((e1 < 0 ? 0 : (e1 >> 1)) * 2048 + CC[i] * 2); } }
    __device__ __forceinline__ void a_ready(const pg8::SUnit& u, int wid) const {
        if (u.flags & pg8::SF_WAIT) {
            if (wid == 0) { unsigned* cnt = ctl + CW_MOE + 64 * u.x2; unsigned sp = 0u;
                while ((unsigned)__builtin_amdgcn_readfirstlane(__hip_atomic_load(cnt, __ATOMIC_RELAXED, __HIP_MEMORY_SCOPE_AGENT)) < 32u) {
                    __builtin_amdgcn_s_sleep(2);
                    if (++sp > (1u << 22)) { if (lane_id_() == 0) __hip_atomic_store(ctl + CW_XTMO, 2u, __ATOMIC_RELAXED, __HIP_MEMORY_SCOPE_AGENT); break; } }
                asm volatile("s_waitcnt vmcnt(0)" ::: "memory"); }
            asm volatile("" ::: "memory"); __builtin_amdgcn_s_barrier(); asm volatile("" ::: "memory");
        } }
    __device__ __forceinline__ void done(const pg8::SUnit& u, int lane) const {
        if (u.flags & pg8::SF_PUBLISH) { asm volatile("s_waitcnt vmcnt(0)" ::: "memory");
            if (lane == 0) __hip_atomic_fetch_add(ctl + CW_MOE + 64 * u.x2, 1u, __ATOMIC_RELAXED, __HIP_MEMORY_SCOPE_AGENT); } }
};
struct MoeEpi {
    const float* RS; bf16_t* HBUF; const float* TW; bf16_t* CT; LAS const int* UL; LAS const int* UD; const int* LISTS;
    __device__ __forceinline__ void operator()(Acc& acc, const pg8::SUnit& u, int wr, int wc, int fr, int fq) const {
        if (u.x3 == 0) {
            const int cb = u.x1 * 128 + 32 * wc + 8 * fq;
            float rsv[2][4];
#pragma unroll
            for (int ai = 0; ai < 2; ++ai)
#pragma unroll
                for (int m = 0; m < 4; ++m) { const int ent = UL[u.x0 * 256 + 128 * ai + 64 * wr + RL(m, fr)]; rsv[ai][m] = (ent >= 0) ? RS[ent >> 1] : 0.f; }
#pragma unroll
            for (int ai = 0; ai < 2; ++ai)
#pragma unroll
                for (int m = 0; m < 4; ++m) { const int r = 128 * ai + 64 * wr + RL(m, fr); const float rs = rsv[ai][m];
                    bf16_t* rp = HBUF + (size_t)(u.x2 * 256 + r) * DE + cb;
                    u32x4 hw;
#pragma unroll
                    for (int n = 0; n < 2; ++n) { const f32x4 g = acc[ai][0][m][n] * rs, up = acc[ai][1][m][n] * rs;
                        const float h0 = g.x * sigmoidf_(g.x) * up.x, h1 = g.y * sigmoidf_(g.y) * up.y, h2 = g.z * sigmoidf_(g.z) * up.z, h3 = g.w * sigmoidf_(g.w) * up.w;
                        hw[2 * n] = pk2(h0, h1); hw[2 * n + 1] = pk2(h2, h3); }
                    asm volatile("global_store_dwordx4 %0, %1, off sc1\n\ts_nop 1" :: "v"(rp), "v"(hw) : "memory");
                    EPI_FENCE(); }
        } else {
            const int cb = u.x1 * 256 + 32 * wc + 8 * fq;
            const int e7 = UD[64 + u.x0 * 8 + 0], nvalid7 = UD[64 + u.x0 * 8 + 3], rt7 = UD[64 + u.x0 * 8 + 4];
            const int* LIST7 = LISTS + (size_t)e7 * T + rt7 * 256;
            int entv[2][4]; float wv[2][4];
#pragma unroll
            for (int ai = 0; ai < 2; ++ai)
#pragma unroll
                for (int m = 0; m < 4; ++m) { const int r = 128 * ai + 64 * wr + RL(m, fr); entv[ai][m] = (r < nvalid7) ? LIST7[r] : -1; }
#pragma unroll
            for (int ai = 0; ai < 2; ++ai)
#pragma unroll
                for (int m = 0; m < 4; ++m) wv[ai][m] = (entv[ai][m] >= 0) ? TW[entv[ai][m]] : 0.f;
#pragma unroll
            for (int ai = 0; ai < 2; ++ai)
#pragma unroll
                for (int m = 0; m < 4; ++m) { const int ent = entv[ai][m];
                    if (ent >= 0) { const float wgt = wv[ai][m]; bf16_t* rp = CT + (size_t)ent * DM + cb;
#pragma unroll
                        for (int bj = 0; bj < 2; ++bj)
#pragma unroll
                            for (int n = 0; n < 2; ++n) { const f32x4 v = acc[ai][bj][m][n] * wgt; *(u32x2*)(rp + 128 * bj + 4 * n) = (u32x2){pk2(v.x, v.y), pk2(v.z, v.w)}; } }
                    EPI_FENCE(); }
        }
    }
};

__device__ __forceinline__ void phase8(const Ctx& C, const Args& a, float* dst) {
    const int tid_ = opaque_tid(C), lane_ = tid_ & 63;
    unsigned char* ws = a.ws;
    const int gw = C.vcu * 8 + C.wave, NGW = C.G * 8;
    const bf16_t* CT = (const bf16_t*)(ws + WS_CONTRIB); bf16_t* XB = (bf16_t*)(ws + WS_X1); bf16_t* PB = (bf16_t*)(ws + WS_PB); float* RS3 = (float*)(ws + WS_RSTD3);
    u32x4 xn[2], c0n[2], c1n[2]; f32x4 pn = {0.f, 0.f, 0.f, 0.f};
#define P8_LOAD(tt) do { const int t_ = (tt); _Pragma("unroll") for (int j = 0; j < 2; ++j) { xn[j] = ((const u32x4*)(XB + (size_t)t_ * DM) + lane_)[64 * j]; \
        c0n[j] = ((const u32x4*)(CT + (size_t)(2 * t_) * DM) + lane_)[64 * j]; c1n[j] = ((const u32x4*)(CT + (size_t)(2 * t_ + 1) * DM) + lane_)[64 * j]; } \
        pn = *((const f32x4*)(a.in[1] + (size_t)t_ * PLE) + lane_); } while (0)
    if (gw < T) P8_LOAD(gw);
    for (int t = gw; t < T; t += NGW) {
        u32x4 xv[2], u0[2], u1[2]; const f32x4 pv = pn;
#pragma unroll
        for (int j = 0; j < 2; ++j) { xv[j] = xn[j]; u0[j] = c0n[j]; u1[j] = c1n[j]; }
        if (t + NGW < T) P8_LOAD(t + NGW);
        float ss = 0.f;
#pragma unroll
        for (int j = 0; j < 2; ++j) { u32x4 o;
#pragma unroll
            for (int q = 0; q < 4; ++q) { const float lo = (bflo(xv[j][q]) + bflo(u0[j][q])) + bflo(u1[j][q]), hi = (bfhi(xv[j][q]) + bfhi(u0[j][q])) + bfhi(u1[j][q]); ss += lo * lo + hi * hi; o[q] = pk2(lo, hi); }
            ((u32x4*)(XB + (size_t)t * DM) + lane_)[64 * j] = o; }
        ss = wave_sum(ss);
        if (lane_ == 0) RS3[t] = 1.0f / sqrtf(ss * (1.0f / DM) + RMS_EPS);
        *((u32x2*)(PB + (size_t)t * PLE) + lane_) = (u32x2){pk2(pv.x, pv.y), pk2(pv.z, pv.w)};
    }
#undef P8_LOAD
}


struct P3Sched {
    const char* Y; const char* WFp; const char* WMp; int vcu, G;
    __device__ __forceinline__ bool next(int i, pg8::GUnit& u) const {
        if (i >= 8) return false; const int Lt = (i >> 1) * G + vcu; if (Lt >= 512) return false;
        const int pm = Lt >> 2, pn = Lt & 3, pass = i & 1; u.x0 = pm; u.x1 = pn; u.x2 = pass; u.x3 = 0;
        u.a0 = Y + (size_t)pass * T * AW * 2 + (size_t)pm * 256 * 1024; u.a1 = u.a0 + (size_t)128 * 1024;
        u.b0 = (pass ? WMp : WFp) + (size_t)pn * 256 * 1024; u.b1 = u.b0 + (size_t)128 * 1024; return true; }
};
struct P3Epi {
    const bf16_t* SA; const bf16_t* SB; bf16_t* MX;
    __device__ __forceinline__ void operator()(Acc& acc, const pg8::GUnit& u, int wr, int wc, int fr, int fq) const {
        const int cb = u.x1 * 256 + 32 * wc + 8 * fq; const bf16_t* G = u.x2 ? SB : SA;
#pragma unroll
        for (int ai = 0; ai < 2; ++ai) {
            u32x4 gv[4][2], pv[4][2];
#pragma unroll
            for (int m = 0; m < 4; ++m) { const size_t ro = (size_t)(u.x0 * 256 + 128 * ai + 64 * wr + RL(m, fr)) * DM + cb;
#pragma unroll
                for (int bj = 0; bj < 2; ++bj) { gv[m][bj] = *(const u32x4*)(G + ro + 128 * bj); if (u.x2) pv[m][bj] = *(const u32x4*)(MX + ro + 128 * bj); } }
#pragma unroll
            for (int m = 0; m < 4; ++m) { const size_t ro = (size_t)(u.x0 * 256 + 128 * ai + 64 * wr + RL(m, fr)) * DM + cb;
#pragma unroll
                for (int bj = 0; bj < 2; ++bj) { const u32x4 g = gv[m][bj]; const f32x4 y = acc[ai][bj][m][0], z = acc[ai][bj][m][1];
                    float r0 = sigmoidf_(bflo(g.x)) * y.x, r1 = sigmoidf_(bfhi(g.x)) * y.y, r2 = sigmoidf_(bflo(g.y)) * y.z, r3 = sigmoidf_(bfhi(g.y)) * y.w,
                          r4 = sigmoidf_(bflo(g.z)) * z.x, r5 = sigmoidf_(bfhi(g.z)) * z.y, r6 = sigmoidf_(bflo(g.w)) * z.z, r7 = sigmoidf_(bfhi(g.w)) * z.w;
                    if (u.x2) { const u32x4 p = pv[m][bj]; r0 += bflo(p.x); r1 += bfhi(p.x); r2 += bflo(p.y); r3 += bfhi(p.y); r4 += bflo(p.z); r5 += bfhi(p.z); r6 += bflo(p.w); r7 += bfhi(p.w); }
                    *(u32x4*)(MX + ro + 128 * bj) = (u32x4){pk2(r0, r1), pk2(r2, r3), pk2(r4, r5), pk2(r6, r7)}; } }
            EPI_FENCE(); }
    }
};
struct P34Sched {
    const char* Y; const char* WFp; const char* WMp; const char* MXp; const char* WOp; unsigned* ctl; int vcu, G, n3, n4;
    __device__ __forceinline__ bool next(int i, pg8::SUnit& u) const {
        if (i < 2 * n3) { const int Lt = (i >> 1) * G + vcu, pm = Lt >> 2, pn = Lt & 3, pass = i & 1; u.x0 = pm; u.x1 = pn; u.x2 = pass; u.x3 = 0;
            u.a0 = Y + (size_t)pass * T * AW * 2 + (size_t)pm * 256 * 1024; u.a1 = u.a0 + (size_t)128 * 1024;
            u.b0 = (pass ? WMp : WFp) + (size_t)pn * 256 * 1024; u.b1 = u.b0 + (size_t)128 * 1024; u.flags = pass ? pg8::SF_PUBLISH : 0; return true; }
        if (i < 2 * n3 + 2 * n4) { const int j = i - 2 * n3, L = (j >> 1) * G + vcu, pm = L >> 2, pn = L & 3, half = j & 1; u.x0 = pm; u.x1 = pn; u.x2 = 0; u.x3 = 1;
            u.a0 = MXp + (size_t)pm * 256 * 2048 + half * 1024; u.a1 = u.a0 + (size_t)128 * 2048; u.b0 = WOp + (size_t)pn * 256 * 2048 + half * 1024; u.b1 = u.b0 + (size_t)128 * 2048;
            u.flags = pg8::SF_PITCH1 | (half == 0 ? (pg8::SF_CHAIN | pg8::SF_WAIT) : pg8::SF_PUBLISH); return true; }
        return false; }
    __device__ __forceinline__ void avoff(const pg8::SUnit&, const int (&)[2], const int (&)[2], unsigned (&)[2], unsigned (&)[2]) const {}
    __device__ __forceinline__ void a_ready(const pg8::SUnit& u, int wid) const {
        if (u.flags & pg8::SF_WAIT) {
            if (wid == 0) { unsigned* cnt = ctl + CW_P34 + 64 * u.x0; unsigned sp = 0u;
                while ((unsigned)__builtin_amdgcn_readfirstlane(__hip_atomic_load(cnt, __ATOMIC_RELAXED, __HIP_MEMORY_SCOPE_AGENT)) < 32u) {
                    __builtin_amdgcn_s_sleep(2);
                    if (++sp > (1u << 22)) { if (lane_id_() == 0) __hip_atomic_store(ctl + CW_XTMO, 3u, __ATOMIC_RELAXED, __HIP_MEMORY_SCOPE_AGENT); break; } }
                __builtin_amdgcn_fence(__ATOMIC_ACQUIRE, "agent");
                asm volatile("s_waitcnt vmcnt(0)" ::: "memory"); }
            asm volatile("" ::: "memory"); __builtin_amdgcn_s_barrier(); asm volatile("" ::: "memory");
        } }
    __device__ __forceinline__ void done(const pg8::SUnit& u, int lane) const {
        if (u.flags & pg8::SF_PUBLISH) { asm volatile("s_waitcnt vmcnt(0)" ::: "memory");
            if (lane == 0) __hip_atomic_fetch_add(ctl + (u.x3 ? CW_P45 : CW_P34) + 64 * u.x0, 1u, __ATOMIC_RELAXED, __HIP_MEMORY_SCOPE_AGENT); } }
};
struct P34Epi {
    static constexpr int NST = 0;
    const bf16_t* SA; const bf16_t* SB; bf16_t* MX; const float* x; bf16_t* xb;
    __device__ __forceinline__ void operator()(Acc& acc, const pg8::SUnit& u, int wr, int wc, int fr, int fq) const {
        const int cb = u.x1 * 256 + 32 * wc + 8 * fq;
        if (u.x3 == 0) {
            const bf16_t* G = u.x2 ? SB : SA;
#pragma unroll
            for (int ai = 0; ai < 2; ++ai) {
                u32x4 gv[4][2], pv[4][2];
#pragma unroll
                for (int m = 0; m < 4; ++m) { const size_t ro = (size_t)(u.x0 * 256 + 128 * ai + 64 * wr + RL(m, fr)) * DM + cb;
#pragma unroll
                    for (int bj = 0; bj < 2; ++bj) { gv[m][bj] = *(const u32x4*)(G + ro + 128 * bj); if (u.x2) pv[m][bj] = *(const u32x4*)(MX + ro + 128 * bj); } }
#pragma unroll
                for (int m = 0; m < 4; ++m) { const size_t ro = (size_t)(u.x0 * 256 + 128 * ai + 64 * wr + RL(m, fr)) * DM + cb;
#pragma unroll
                    for (int bj = 0; bj < 2; ++bj) { const u32x4 g = gv[m][bj]; const f32x4 y = acc[ai][bj][m][0], z = acc[ai][bj][m][1];
                        float r0 = sigmoid2_(bflo(g.x)) * y.x, r1 = sigmoid2_(bfhi(g.x)) * y.y, r2 = sigmoid2_(bflo(g.y)) * y.z, r3 = sigmoid2_(bfhi(g.y)) * y.w,
                              r4 = sigmoid2_(bflo(g.z)) * z.x, r5 = sigmoid2_(bfhi(g.z)) * z.y, r6 = sigmoid2_(bflo(g.w)) * z.z, r7 = sigmoid2_(bfhi(g.w)) * z.w;
                        if (u.x2) { const u32x4 p = pv[m][bj]; r0 += bflo(p.x); r1 += bfhi(p.x); r2 += bflo(p.y); r3 += bfhi(p.y); r4 += bflo(p.z); r5 += bfhi(p.z); r6 += bflo(p.w); r7 += bfhi(p.w); }
                        const u32x4 ov = {pk2(r0, r1), pk2(r2, r3), pk2(r4, r5), pk2(r6, r7)}; bf16_t* rp = MX + ro + 128 * bj;
                        if (u.x2) asm volatile("global_store_dwordx4 %0, %1, off sc1\n\ts_nop 1" :: "v"(rp), "v"(ov) : "memory");
                        else *(u32x4*)rp = ov; } }
                EPI_FENCE(); }
        } else {
#pragma unroll
            for (int ai = 0; ai < 2; ++ai)
#pragma unroll
                for (int mh = 0; mh < 2; ++mh) {
                    f32x4 xv[2][2][2];
#pragma unroll
                    for (int m2 = 0; m2 < 2; ++m2) { const size_t ro = (size_t)(u.x0 * 256 + 128 * ai + 64 * wr + RL(2 * mh + m2, fr)) * DM + cb;
#pragma unroll
                        for (int bj = 0; bj < 2; ++bj)
#pragma unroll
                            for (int n = 0; n < 2; ++n) xv[m2][bj][n] = *(const f32x4*)(x + ro + 128 * bj + 4 * n); }
#pragma unroll
                    for (int m2 = 0; m2 < 2; ++m2) { const int m = 2 * mh + m2; const size_t ro = (size_t)(u.x0 * 256 + 128 * ai + 64 * wr + RL(m, fr)) * DM + cb;
#pragma unroll
                        for (int bj = 0; bj < 2; ++bj) { const f32x4 v = xv[m2][bj][0] + acc[ai][bj][m][0], w = xv[m2][bj][1] + acc[ai][bj][m][1];
                            const u32x4 ov = {pk2(v.x, v.y), pk2(v.z, v.w), pk2(w.x, w.y), pk2(w.z, w.w)}; bf16_t* rp = xb + ro + 128 * bj;
                            asm volatile("global_store_dwordx4 %0, %1, off sc1\n\ts_nop 1" :: "v"(rp), "v"(ov) : "memory"); } }
                    EPI_FENCE(); }
        }
    }
};
struct P9Sched {
    const char* A; const char* B; int rowbytes, vcu, G;
    __device__ __forceinline__ bool next(int i, pg8::GUnit& u) const {
        const int Lt = i * G + vcu; if (Lt >= 512) return false;
        const int pm = Lt >> 2, pn = Lt & 3; u.x0 = pm; u.x1 = pn; u.x2 = 0; u.x3 = 0;
        u.a0 = A + (size_t)pm * 256 * rowbytes; u.a1 = u.a0 + (size_t)128 * rowbytes; u.b0 = B + (size_t)pn * 256 * rowbytes; u.b1 = u.b0 + (size_t)128 * rowbytes; return true; }
};
struct P9EpiA {
    bf16_t* PPB;
    __device__ __forceinline__ void operator()(Acc& acc, const pg8::GUnit& u, int wr, int wc, int fr, int fq) const {
        const int cb = u.x1 * 256 + 32 * wc + 8 * fq;
#pragma unroll
        for (int ai = 0; ai < 2; ++ai)
#pragma unroll
            for (int m = 0; m < 4; ++m) { bf16_t* rp = PPB + (size_t)(u.x0 * 256 + 128 * ai + 64 * wr + RL(m, fr)) * DM + cb;
#pragma unroll
                for (int bj = 0; bj < 2; ++bj)
#pragma unroll
                    for (int n = 0; n < 2; ++n) { const f32x4 v = acc[ai][bj][m][n]; *(u32x2*)(rp + 128 * bj + 4 * n) = (u32x2){pk2(v.x, v.y), pk2(v.z, v.w)}; }
                EPI_FENCE(); }
    }
};
struct P9EpiB {
    const bf16_t* PPB; const bf16_t* XB; const float* RS3; float* out; const float* gfin; float* xslot; unsigned* ctl; LAS unsigned char* tail;
    __device__ __forceinline__ void operator()(Acc& acc, const pg8::GUnit& u, int wr, int wc, int fr, int fq) const {
        const int tid = 256 * wr + 64 * wc + 16 * fq + fr, wid = 4 * wr + wc;
        const int cb = u.x1 * 256 + 32 * wc + 8 * fq;
        LAS float* P = (LAS float*)tail; LAS float* S = (LAS float*)(tail + 4096);
#pragma unroll
        for (int ai = 0; ai < 2; ++ai)
#pragma unroll
            for (int mh = 0; mh < 2; ++mh) {
                float rsv[2]; u32x4 ppv[2][2], xvv[2][2];
#pragma unroll
                for (int m2 = 0; m2 < 2; ++m2) { const int row = u.x0 * 256 + 128 * ai + 64 * wr + RL(2 * mh + m2, fr); rsv[m2] = RS3[row]; const size_t ro = (size_t)row * DM + cb;
#pragma unroll
                    for (int bj = 0; bj < 2; ++bj) { ppv[m2][bj] = *(const u32x4*)(PPB + ro + 128 * bj); xvv[m2][bj] = *(const u32x4*)(XB + ro + 128 * bj); } }
#pragma unroll
                for (int m2 = 0; m2 < 2; ++m2) { const int m = 2 * mh + m2; const float rs = rsv[m2]; float s = 0.f;
#pragma unroll
                    for (int bj = 0; bj < 2; ++bj)
#pragma unroll
                        for (int n = 0; n < 2; ++n) { const f32x4 g = acc[ai][bj][m][n] * (rs * -1.4426950408889634f); const unsigned pl = n ? ppv[m2][bj].z : ppv[m2][bj].x, ph = n ? ppv[m2][bj].w : ppv[m2][bj].y, xl = n ? xvv[m2][bj].z : xvv[m2][bj].x, xh = n ? xvv[m2][bj].w : xvv[m2][bj].y;
                            f32x4 v = {bflo(xl), bfhi(xl), bflo(xh), bfhi(xh)};
                            v.x += sigmoid2_(g.x) * bflo(pl); v.y += sigmoid2_(g.y) * bfhi(pl); v.z += sigmoid2_(g.z) * bflo(ph); v.w += sigmoid2_(g.w) * bfhi(ph);
                            acc[ai][bj][m][n] = v; s += (v.x * v.x + v.y * v.y) + (v.z * v.z + v.w * v.w); }
                    s += __shfl_xor(s, 16); s += __shfl_xor(s, 32);
                    if (fq == 0) P[(128 * ai + 64 * wr + RL(m, fr)) * 4 + wc] = s; }
                EPI_FENCE(); }
        asm volatile("s_waitcnt lgkmcnt(0)" ::: "memory"); __builtin_amdgcn_s_barrier(); asm volatile("" ::: "memory");
        unsigned* cnt = ctl + CW_XCNT + 64 * u.x0;
        if (tid < 256) { const f32x4 q = *(LAS const f32x4*)(P + tid * 4); const float tot = (q.x + q.y) + (q.z + q.w);
            __hip_atomic_store((unsigned*)xslot + (size_t)(u.x0 * 256 + tid) * 4 + u.x1, __float_as_uint(tot), __ATOMIC_RELAXED, __HIP_MEMORY_SCOPE_AGENT); }
        asm volatile("s_waitcnt vmcnt(0)" ::: "memory");
        if (wid < 4 && (tid & 63) == 0) __hip_atomic_fetch_add(cnt, 1u, __ATOMIC_RELAXED, __HIP_MEMORY_SCOPE_AGENT);
        if (wid == 0) {
            unsigned sp = 0u;
            while ((unsigned)__builtin_amdgcn_readfirstlane(__hip_atomic_load(cnt, __ATOMIC_RELAXED, __HIP_MEMORY_SCOPE_AGENT)) < 16u) {
                __builtin_amdgcn_s_sleep(2);
                if (++sp > (1u << 22)) { if ((tid & 63) == 0) __hip_atomic_store(ctl + CW_XTMO, 1u, __ATOMIC_RELAXED, __HIP_MEMORY_SCOPE_AGENT); break; } }
            __builtin_amdgcn_fence(__ATOMIC_ACQUIRE, "agent");
        }
        asm volatile("s_waitcnt vmcnt(0) lgkmcnt(0)" ::: "memory"); __builtin_amdgcn_s_barrier(); asm volatile("" ::: "memory");
        if (tid < 256) { const unsigned* sl = (const unsigned*)xslot + (size_t)(u.x0 * 256 + tid) * 4; float tot = 0.f;
#pragma unroll
            for (int t4 = 0; t4 < 4; ++t4) tot += __uint_as_float(__hip_atomic_load(sl + t4, __ATOMIC_RELAXED, __HIP_MEMORY_SCOPE_AGENT));
            S[tid] = 1.0f / sqrtf(tot * (1.0f / DM) + RMS_EPS); }
        asm volatile("s_waitcnt vmcnt(0) lgkmcnt(0)" ::: "memory"); __builtin_amdgcn_s_barrier(); asm volatile("" ::: "memory");
        f32x4 gv[2][2];
#pragma unroll
        for (int bj = 0; bj < 2; ++bj)
#pragma unroll
            for (int n = 0; n < 2; ++n) gv[bj][n] = *(const f32x4*)(gfin + cb + 128 * bj + 4 * n);
#pragma unroll
        for (int ai = 0; ai < 2; ++ai)
#pragma unroll
            for (int m = 0; m < 4; ++m) { const int rl = 128 * ai + 64 * wr + RL(m, fr); const float rstd = S[rl]; float* rp = out + (size_t)(u.x0 * 256 + rl) * DM + cb;
#pragma unroll
                for (int bj = 0; bj < 2; ++bj)
#pragma unroll
                    for (int n = 0; n < 2; ++n) *(f32x4*)(rp + 128 * bj + 4 * n) = acc[ai][bj][m][n] * rstd * gv[bj][n];
                EPI_FENCE(); }
        asm volatile("s_waitcnt lgkmcnt(0)" ::: "memory"); __builtin_amdgcn_s_barrier(); asm volatile("" ::: "memory");
    }
};

__global__ void __launch_bounds__(512, 2) fwd_kernel(Args args) {
    extern __shared__ __attribute__((aligned(16))) unsigned char lds_raw[];
    Ctx C;
    C.lds = (LAS unsigned char*)lds_raw;
    C.wave = __builtin_amdgcn_readfirstlane((int)threadIdx.x >> 6);
    C.G = gridDim.x; { const int bx = blockIdx.x; C.vcu = (C.G % 8 == 0) ? (bx % 8) * (C.G / 8) + bx / 8 : bx; }
    volatile LAS unsigned* MISC = (volatile LAS unsigned*)(C.lds + MISC_OFF);
    LAS int* TST = (LAS int*)(C.lds + MISC_OFF + 256);
    for (int u = opaque_tid(C); u < (LDS_BYTES - MISC_OFF) / 4; u += 512) ((LAS unsigned*)(C.lds + MISC_OFF))[u] = 0u;
    __syncthreads();
    unsigned* ctl = (unsigned*)(args.ws + WS_CTL);
    XcdBarrier bar; bar.bar = ctl + CW_BAR; bar.x = 0; bar.st = nullptr; bar.wave = C.wave;
    const int lo = args.ph_lo, hi = args.ph_hi;
    if (hi - lo > 1) bar = xcd_barrier_post(ctl + CW_BAR, MISC + 8, C.wave);
#define IN(k) (lo <= (k) && (k) < hi)
#define SEAM(k) do { if (IN(k) && IN((k) + 1)) xcd_barrier(bar); } while (0)

    if (IN(0)) { phase0(C, args); } SEAM(0);
    if (IN(1)) {
        p1_cumsum(C, args);
        { P1Sched S{(const char*)(args.ws + WS_HB), (const char*)(args.ws + WS_W1), (const char*)(args.ws + WS_WV), C.vcu, C.G}; P1Epi E{args.ws};
          pg8::gemm_phase<false>(C.lds, C.wave, 1024, S, E); }
    } SEAM(1);
    if (IN(2)) {
        for (int task = C.vcu * 8 + C.wave; task < 64 * 16 * 8; task += 4 * C.G * 8) moba_select4(C, args, task, C.G * 8);
        if ((C.wave == 0 && lane_id_() == 0)) __hip_atomic_fetch_add(ctl + CW_SELDONE, 1u, __ATOMIC_RELAXED, __HIP_MEMORY_SCOPE_AGENT);
        LAS int* PFX = (LAS int*)(C.lds + MISC_OFF + 1024);
        if ((C.wave == 0 && lane_id_() == 0)) PFX[1025] = 0x7fffffff;
        unsigned nxt_u = 0u;
        if ((C.wave == 0 && lane_id_() == 0)) nxt_u = __hip_atomic_fetch_add(ctl + CW_ATTCTR, 1u, __ATOMIC_RELAXED, __HIP_MEMORY_SCOPE_AGENT);
        for (;;) {
            if ((C.wave == 0 && lane_id_() == 0)) MISC[16] = nxt_u;
            __syncthreads();
            const int u = (int)MISC[16];
            __syncthreads();
            if (PFX[1025] == 0x7fffffff && (u % 11 != 10) && (u - u / 11) >= 1024) {
                if ((C.wave == 0 && lane_id_() == 0)) { unsigned sp = 0u;
                    while (__hip_atomic_load(ctl + CW_SELDONE, __ATOMIC_RELAXED, __HIP_MEMORY_SCOPE_AGENT) < (unsigned)C.G) { __builtin_amdgcn_s_sleep(2);
                        if (++sp > (1u << 22)) { __hip_atomic_store(ctl + CW_XTMO, 5u, __ATOMIC_RELAXED, __HIP_MEMORY_SCOPE_AGENT); break; } } }
                __syncthreads();
                const int t_ = opaque_tid(C), ln_ = t_ & 63;
                const unsigned* LC = (const unsigned*)(args.ws + WS_CTL) + CW_LCNT;
                const int n0 = (int)((__hip_atomic_load(LC + 32 * (2 * t_), __ATOMIC_RELAXED, __HIP_MEMORY_SCOPE_AGENT) + GCHUNK - 1) / GCHUNK);
                const int n1 = (int)((__hip_atomic_load(LC + 32 * (2 * t_ + 1), __ATOMIC_RELAXED, __HIP_MEMORY_SCOPE_AGENT) + GCHUNK - 1) / GCHUNK);
                int inc = n0 + n1;
                for (int o = 1; o < 64; o <<= 1) { const int nb = __shfl_up(inc, o); if (ln_ >= o) inc += nb; }
                LAS int* WT = (LAS int*)(C.lds + MISC_OFF + 512);
                if (ln_ == 63) WT[C.wave] = inc;
                __syncthreads();
                int wbase = 0; for (int w_ = 0; w_ < C.wave; ++w_) wbase += WT[w_];
                const int ex = wbase + inc - (n0 + n1);
                PFX[2 * t_] = ex; PFX[2 * t_ + 1] = ex + n0;
                if (t_ == 511) { PFX[1024] = ex + n0 + n1; PFX[1025] = max(11 * N_CONV_CHUNKS, ((2048 + ex + n0 + n1) * 11 + 9) / 10 + 1); }
                __syncthreads();
            }
            if (u >= PFX[1025]) break;
            if ((C.wave == 0 && lane_id_() == 0)) nxt_u = __hip_atomic_fetch_add(ctl + CW_ATTCTR, 1u, __ATOMIC_RELAXED, __HIP_MEMORY_SCOPE_AGENT);
            if (u % 11 != 10) { const int au = u - u / 11; const int NG = (au < 1024) ? 0 : PFX[1024], NA = 2048 + NG;
                if (au < 1024) attn_unit(C, args, 0, au & 63, 15 - (au >> 6));
                else if (au >= 1024 + NG && au < NA) { const int it = au - 1024 - NG, bh = it >> 4, qb = 15 - (it & 15);
                    if (qb > 0) { const unsigned need = (unsigned)(PFX[(bh + 1) * 16] - PFX[bh * 16]);
                        if ((C.wave == 0 && lane_id_() == 0)) { unsigned sp = 0u;
                            while (__hip_atomic_load(ctl + CW_GDONE + 32 * bh, __ATOMIC_RELAXED, __HIP_MEMORY_SCOPE_AGENT) < need) { __builtin_amdgcn_s_sleep(2);
                                if (++sp > (1u << 22)) { __hip_atomic_store(ctl + CW_XTMO, 6u, __ATOMIC_RELAXED, __HIP_MEMORY_SCOPE_AGENT); break; } } }
                        __syncthreads(); }
                    moba_own_item(C, args, bh, qb); }
                else if (au < 1024 + NG) { const int g = au - 1024; int lo_ = 0, hi_ = 1024;
                    while (hi_ - lo_ > 1) { const int mid = (lo_ + hi_) >> 1; if (PFX[mid] <= g) lo_ = mid; else hi_ = mid; }
                    const int len = (int)__hip_atomic_load((const unsigned*)(args.ws + WS_CTL) + CW_LCNT + 32 * lo_, __ATOMIC_RELAXED, __HIP_MEMORY_SCOPE_AGENT);
                    moba_gather_item(C, args, lo_, g - PFX[lo_], __builtin_amdgcn_readfirstlane(len)); } }
            else {
                const int lane_c = opaque_tid(C) & 63; LAS float* scr = (LAS float*)(C.lds + C.wave * 8704);
                { const int itb = P0_EARLY + (u / 11) * CONV_CHUNK + C.wave; const int n = (itb < P0_NIT) ? min(CONV_CHUNK / 8, (P0_NIT - itb + 7) / 8) : 0; p0_weight_run(args, itb, 8, n, scr, lane_c); }
                __syncthreads();
            }
        }
    } SEAM(2);
    if (IN(3)) {
        int n3 = 0, n4 = 0; for (int i = 0; i < 4; ++i) { if (i * C.G + C.vcu < 512) { ++n3; ++n4; } }
        P34Sched S{(const char*)(args.ws + WS_HB), (const char*)(args.ws + WS_WF), (const char*)(args.ws + WS_WM), (const char*)(args.ws + WS_MIXED), (const char*)(args.ws + WS_WO), ctl, C.vcu, C.G, n3, n4};
        P34Epi E{(const bf16_t*)(args.ws + WS_SA), (const bf16_t*)(args.ws + WS_SB), (bf16_t*)(args.ws + WS_MIXED), args.in[0], (bf16_t*)(args.ws + WS_X1)};
        pg8::gemm_stream(C.lds, C.wave, 512, 1024, S, E);
        for (int u0 = C.vcu * 8; u0 < T / 16; u0 += C.G * 8) {
            if (C.wave == 0) { unsigned* cnt = ctl + CW_P45 + 64 * (u0 >> 4); unsigned sp = 0u;
                while ((unsigned)__builtin_amdgcn_readfirstlane(__hip_atomic_load(cnt, __ATOMIC_RELAXED, __HIP_MEMORY_SCOPE_AGENT)) < 32u) {
                    __builtin_amdgcn_s_sleep(2);
                    if (++sp > (1u << 22)) { if (lane_id_() == 0) __hip_atomic_store(ctl + CW_XTMO, 4u, __ATOMIC_RELAXED, __HIP_MEMORY_SCOPE_AGENT); break; } }
                __builtin_amdgcn_fence(__ATOMIC_ACQUIRE, "agent");
                asm volatile("s_waitcnt vmcnt(0)" ::: "memory"); }
            __syncthreads();
            p5_wave<true>(C, args, u0 + C.wave); }
    } SEAM(5);
    if (IN(6)) {
        const int nun = moe_prepare(C, args, TST);
        int n6 = 0, n7; for (int i = 0; i < 8; ++i) if (i * C.G + C.vcu < nun) ++n6;
        (void)moe_down_unit(nun, C.vcu, C.G, 0, n7);
        MoeSched S{(const char*)(args.ws + WS_X1), (const char*)(args.ws + WS_WG), (const char*)(args.ws + WS_WU), (const char*)(args.ws + WS_HBUF), (const char*)(args.ws + WS_WD),
                   (LAS const int*)(C.lds + UD_OFF), (LAS const int*)(C.lds + UL_OFF), ctl, n6, n7};
        MoeEpi E{(const float*)(args.ws + WS_RSTD2), (bf16_t*)(args.ws + WS_HBUF), (const float*)(args.ws + WS_TOKW), (bf16_t*)(args.ws + WS_CONTRIB), (LAS const int*)(C.lds + UL_OFF), (LAS const int*)(C.lds + UD_OFF), (const int*)(args.ws + WS_LISTS)};
        pg8::gemm_stream(C.lds, C.wave, 512, 1024, S, E);
    } SEAM(7);
    if (IN(8)) { phase8(C, args, args.out); } SEAM(8);
    if (IN(9)) {
        { P9Sched S{(const char*)(args.ws + WS_PB), (const char*)(args.ws + WS_WPP), 512, C.vcu, C.G}; P9EpiA E{(bf16_t*)(args.ws + WS_QF)};
          pg8::gemm_phase<false>(C.lds, C.wave, 256, S, E); }
        { P9Sched S{(const char*)(args.ws + WS_X1), (const char*)(args.ws + WS_WPG), 2048, C.vcu, C.G}; P9EpiB E{(const bf16_t*)(args.ws + WS_QF), (const bf16_t*)(args.ws + WS_X1), (const float*)(args.ws + WS_RSTD3), args.out, args.in[19], (float*)(args.ws + WS_XSLOT), ctl, C.lds + MISC_OFF + 4096};
          pg8::gemm_phase<false>(C.lds, C.wave, 1024, S, E); }
    }
#undef IN
#undef SEAM
}

extern "C" void kernel_launch(void* const* d_in, const int* in_sizes, int n_in, void* d_out, int out_size, void* d_ws, size_t ws_size, hipStream_t stream) {
    static int grid = 0;
    if (grid == 0) {
        if (n_in != 20 || in_sizes[0] != T * DM || out_size != T * DM || ws_size < WS_END) { fprintf(stderr, "kernel_launch: unexpected shapes (n_in %d, ws %zu)\n", n_in, ws_size); grid = -1; return; }
        int dev = 0, cus = 0, per_cu = 0;
        if (hipGetDevice(&dev) != hipSuccess || hipDeviceGetAttribute(&cus, hipDeviceAttributeMultiprocessorCount, dev) != hipSuccess) { grid = -1; return; }
        if (hipFuncSetAttribute((const void*)fwd_kernel, hipFuncAttributeMaxDynamicSharedMemorySize, LDS_BYTES) != hipSuccess) { fprintf(stderr, "kernel_launch: hipFuncSetAttribute failed\n"); grid = -1; return; }
        if (hipOccupancyMaxActiveBlocksPerMultiprocessor(&per_cu, (const void*)fwd_kernel, 512, LDS_BYTES) != hipSuccess || per_cu < 1) { fprintf(stderr, "kernel_launch: occupancy query says %d blocks/CU\n", per_cu); (void)hipGetLastError(); grid = -1; return; }
        grid = cus;
    }
    if (grid < 0) return;
    if (hipMemsetAsync((char*)d_ws + WS_CTL, 0, CTL_BYTES, stream) != hipSuccess) return;
    Args a{};
    for (int i = 0; i < 20; ++i) a.in[i] = (const float*)d_in[i];
    a.out = (float*)d_out; a.ws = (unsigned char*)d_ws;
    if (MK_N_LAUNCHES == 1) {
        a.ph_lo = 0; a.ph_hi = NPH;
        hipLaunchKernelGGL(fwd_kernel, dim3(grid), dim3(512), LDS_BYTES, stream, a);
    } else {
        for (int p = 0; p < NPH; ++p) { a.ph_lo = p; a.ph_hi = p + 1; hipLaunchKernelGGL(fwd_kernel, dim3(grid), dim3(512), LDS_BYTES, stream, a); }
    }
}
```

```cpp
#include <hip/hip_runtime.h>
#include <cstdio>
#include <cstdint>

#ifndef MK_N_LAUNCHES
#define MK_N_LAUNCHES 1
#endif

#define LAS __attribute__((address_space(3)))
typedef unsigned short bf16_t;
typedef short bf16x8 __attribute__((ext_vector_type(8)));
typedef short s16x4 __attribute__((ext_vector_type(4)));
typedef float f32x2 __attribute__((ext_vector_type(2)));
typedef float f32x4 __attribute__((ext_vector_type(4)));
typedef float f32x16 __attribute__((ext_vector_type(16)));
typedef unsigned u32x2 __attribute__((ext_vector_type(2)));
typedef unsigned u32x4 __attribute__((ext_vector_type(4)));
typedef __bf16 bf16x2_t __attribute__((ext_vector_type(2)));

constexpr int NB = 8, SEQ = 4096, T = NB * SEQ, DM = 1024, NH = 8, HD = 64, AW = 512, PLE = 256, NE = 32, DE = 512, INC = 5128;
constexpr int NPH = 11;
constexpr float RMS_EPS = 1e-6f;
constexpr float LOG2E = 1.4426950408889634f;
constexpr float QSCALE = 0.125f * LOG2E;

constexpr size_t MiB_ = 1u << 20;
constexpr size_t XS_SEL = 0;
constexpr size_t XS_LIST = 2 * MiB_;
constexpr size_t XS_ML = 10 * MiB_;
constexpr size_t XS_PART = 16 * MiB_;
constexpr int LIST_CAP = 3840, GCHUNK = 1024;
constexpr size_t MiB = 1u << 20;
constexpr size_t WS_CTL = 0, CTL_BYTES = 1 * MiB;
constexpr size_t WS_W1 = 1 * MiB;
constexpr size_t WS_WV = 9 * MiB;
constexpr size_t WS_WF = 11 * MiB;
constexpr size_t WS_WM = 12 * MiB;
constexpr size_t WS_WO = 13 * MiB;
constexpr size_t WS_WPG = 15 * MiB;
constexpr size_t WS_WPP = 17 * MiB;
constexpr size_t WS_WG = 18 * MiB;
constexpr size_t WS_WU = 50 * MiB;
constexpr size_t WS_WD = 82 * MiB;
constexpr size_t WS_COS = 114 * MiB;
constexpr size_t WS_SIN = WS_COS + 512 * 1024;
constexpr size_t WS_LOGF = 115 * MiB;
constexpr size_t WS_C2 = 116 * MiB;
constexpr size_t WS_KMP = 117 * MiB;
constexpr size_t WS_RSTD2 = 118 * MiB;
constexpr size_t WS_RSTD3 = WS_RSTD2 + 128 * 1024;
constexpr size_t WS_TOKW = WS_RSTD3 + 128 * 1024;
constexpr size_t WS_LISTS = 119 * MiB;
constexpr size_t WS_WRH = 124 * MiB;
constexpr size_t WS_WRL = WS_WRH + 98304;
constexpr size_t WS_XSLOT = 125 * MiB;
constexpr size_t WS_HB = 128 * MiB;
constexpr size_t WS_QF = 192 * MiB, WS_KF = 224 * MiB, WS_QM = 256 * MiB, WS_KM = 288 * MiB;
constexpr size_t WS_CONTRIB = 128 * MiB;
constexpr size_t WS_X1 = 256 * MiB;
constexpr size_t WS_VT = 320 * MiB;
constexpr size_t WS_MIXED = 320 * MiB, WS_PB = 320 * MiB;
constexpr size_t WS_SA = 384 * MiB, WS_SB = 448 * MiB;
constexpr size_t WS_HBUF = 384 * MiB;
constexpr size_t WS_END = 512 * MiB;

constexpr int CW_ATTCTR = 8;
constexpr int CW_CNT = 8192;
constexpr int CW_KMAX = 16384;
constexpr int CW_BAR = 4096;
constexpr int CW_XCNT = 32768;
constexpr int CW_XTMO = 2;
constexpr int CW_LCNT = 196608;
constexpr int CW_SELDONE = 12;
constexpr int CW_GDONE = 229376;
constexpr int CW_P34 = 131072;
constexpr int CW_P45 = 163840;
constexpr int CW_MOE = 65536;

constexpr int LDS_BYTES = 163840;
constexpr int MISC_OFF = 131072;

__device__ __forceinline__ unsigned pk2(float lo, float hi) { f32x2 v = {lo, hi}; bf16x2_t b = __builtin_convertvector(v, bf16x2_t); return __builtin_bit_cast(unsigned, b); }
__device__ __forceinline__ float bflo(unsigned u) { return __builtin_bit_cast(float, u << 16); }
__device__ __forceinline__ float bfhi(unsigned u) { return __builtin_bit_cast(float, u & 0xffff0000u); }
__device__ __forceinline__ float xhalf_max(float x) { const auto r = __builtin_amdgcn_permlane32_swap(__float_as_uint(x), __float_as_uint(x), false, false); return __builtin_fmaxf(__uint_as_float(r[0]), __uint_as_float(r[1])); }
__device__ __forceinline__ float xhalf_sum(float x) { const auto r = __builtin_amdgcn_permlane32_swap(__float_as_uint(x), __float_as_uint(x), false, false); return __uint_as_float(r[0]) + __uint_as_float(r[1]); }
__device__ __forceinline__ float xhalf_lo(float x) { const auto r = __builtin_amdgcn_permlane32_swap(__float_as_uint(x), __float_as_uint(x), false, false); return __uint_as_float(r[0]); }
__device__ __forceinline__ float bf2f(short s) { return __builtin_bit_cast(float, ((unsigned)(unsigned short)s) << 16); }
__device__ __forceinline__ float wave_sum(float v) {
#pragma unroll
    for (int o = 1; o < 64; o <<= 1) v += __shfl_xor(v, o);
    return v;
}
__device__ __forceinline__ float sigmoidf_(float x) { return __builtin_amdgcn_rcpf(1.0f + __builtin_amdgcn_exp2f(x * -1.4426950408889634f)); }

__device__ __forceinline__ float sigmoid2_(float x2) { return __builtin_amdgcn_rcpf(1.0f + __builtin_amdgcn_exp2f(x2)); }
#define EPI_FENCE() asm volatile("" ::: "memory")
#define RL(m, fr) (32 * ((m) >> 1) + 8 * ((fr) >> 2) + 4 * ((m) & 1) + ((fr) & 3))
#define XB_TMO      128
#define XB_XCNT(j)  (256  + 64 * (j))
#define XB_XSUB(j)  (1280 + 64 * (j))
#define XB_XGEN(j)  (2304 + 64 * (j))
#define XB_TOP      3328
#define XB_TOPGEN   3392
#define XCD_BAR_WORDS 3456
#define XB_SPIN_CAP (1u << 22)
__device__ __forceinline__ unsigned xb_ld(unsigned* p)              { return __hip_atomic_load(p, __ATOMIC_RELAXED, __HIP_MEMORY_SCOPE_AGENT); }
__device__ __forceinline__ unsigned xb_add(unsigned* p, unsigned v) { return __hip_atomic_fetch_add(p, v, __ATOMIC_RELAXED, __HIP_MEMORY_SCOPE_AGENT); }
__device__ __forceinline__ unsigned xb_xcc_id() { return (unsigned)__builtin_amdgcn_s_getreg((3 << 11) | 20) & 0xFu; }
#define XB_SPIN(cond, bar) do { unsigned _sp = 0; while (cond) { __builtin_amdgcn_s_sleep(1); \
    if ((++_sp & 255u) == 0u) { if (xb_ld(&(bar)[XB_TMO])) break; if (_sp > XB_SPIN_CAP) { atomicAdd(&(bar)[XB_TMO], 1u); break; } } } } while (0)
__device__ __forceinline__ int lane_id_() { int l; asm volatile("v_mbcnt_lo_u32_b32 %0, -1, 0\n\tv_mbcnt_hi_u32_b32 %0, -1, %0" : "=v"(l)); return l; }
struct XcdBarrier { unsigned* bar; unsigned x; volatile LAS unsigned* st; int wave; };
__device__ __forceinline__ XcdBarrier xcd_barrier_post(unsigned* bar, volatile LAS unsigned* st, const int wave) {
    XcdBarrier b; b.bar = bar; b.x = xb_xcc_id(); b.st = st; b.wave = wave;
    if (wave == 0 && lane_id_() == 0) (void)xb_add(&bar[XB_XCNT(b.x)], 1u);
    return b;
}
__device__ __forceinline__ void xcd_barrier_complete(unsigned* bar, unsigned x, unsigned& nloc, unsigned& nx) {
    const unsigned G = gridDim.x * gridDim.y * gridDim.z;
    unsigned sum, cnt, mine, sp = 0u;
    for (;;) {
        sum = 0u; cnt = 0u; mine = 0u;
#pragma unroll
        for (unsigned j = 0; j < 16; ++j) { const unsigned c = xb_ld(&bar[XB_XCNT(j)]); sum += c; cnt += (c > 0u) ? 1u : 0u; mine = (j == x) ? c : mine; }
        if (sum == G) break;
        __builtin_amdgcn_s_sleep(1);
        if ((++sp & 255u) == 0u) { if (xb_ld(&bar[XB_TMO])) break; if (sp > XB_SPIN_CAP) { atomicAdd(&bar[XB_TMO], 1u); break; } }
    }
    nloc = mine > 0u ? mine : 1u; nx = cnt > 0u ? cnt : 1u;
}
__device__ __forceinline__ void xcd_barrier(const XcdBarrier& b) {
    asm volatile("s_waitcnt vmcnt(0)" ::: "memory");
    __syncthreads();
    if (b.wave == 0 && lane_id_() == 0) {
        unsigned* bar = b.bar;
        __builtin_amdgcn_s_waitcnt(0);
        unsigned nloc = b.st[0], nx = b.st[1];
        if (nloc == 0u) { xcd_barrier_complete(bar, b.x, nloc, nx); b.st[0] = nloc; b.st[1] = nx; }
        const unsigned old = xb_add(&bar[XB_XSUB(b.x)], 1u);
        const unsigned gen = old / nloc;
        if (old + 1u == (gen + 1u) * nloc) {
            __builtin_amdgcn_fence(__ATOMIC_RELEASE, "agent");
            asm volatile("s_waitcnt vmcnt(0)" ::: "memory");
            const unsigned og = xb_add(&bar[XB_TOP], 1u);
            const unsigned tg = og / nx;
            if (og + 1u == (tg + 1u) * nx) xb_add(&bar[XB_TOPGEN], 1u);
            else XB_SPIN(xb_ld(&bar[XB_TOPGEN]) == tg, bar);
            __builtin_amdgcn_fence(__ATOMIC_ACQUIRE, "agent");
            xb_add(&bar[XB_XGEN(b.x)], 1u);
            asm volatile("s_waitcnt vmcnt(0)" ::: "memory");
        } else {
            XB_SPIN(xb_ld(&bar[XB_XGEN(b.x)]) == gen, bar);
            __builtin_amdgcn_fence(__ATOMIC_ACQUIRE, "agent");
            asm volatile("s_waitcnt vmcnt(0)" ::: "memory");
        }
    }
    __syncthreads();
}

struct Args {
    const float* in[20];
    float* out;
    unsigned char* ws;
    int ph_lo, ph_hi;
};

struct Ctx {
    LAS unsigned char* lds;
    int wave, vcu, G;
};
__device__ __forceinline__ int opaque_tid(const int wave) { int t = (wave << 6) | lane_id_(); asm volatile("" : "+v"(t)); return t; }
__device__ __forceinline__ int opaque_tid(const Ctx& C) { return opaque_tid(C.wave); }


typedef f32x4 Acc[2][2][4][2];

__device__ __forceinline__ void acc_zero(Acc& acc) {
#pragma unroll
    for (int a = 0; a < 2; ++a)
#pragma unroll
        for (int b = 0; b < 2; ++b)
#pragma unroll
            for (int m = 0; m < 4; ++m)
#pragma unroll
                for (int n = 0; n < 2; ++n) acc[a][b][m][n] = (f32x4){0.f, 0.f, 0.f, 0.f};
}


namespace pg8 {
constexpr int BK = 64, HALF = 128, HTB = HALF * BK * 2;
__device__ __forceinline__ int lds_byte(int r, int c) { const int st = (r >> 4) * 2 + (c >> 5), rr = r & 15, cc = c & 31, ob = rr * 64 + cc * 2; return st * 1024 + (ob ^ (((ob >> 9) & 1) << 5)); }
__device__ __forceinline__ int perm32(int rho) { const int n = rho >> 4, i = rho & 15; return 8 * (i >> 2) + 4 * n + (i & 3); }
__device__ __forceinline__ void stage_rc(int b, int& R, int& Cc) { const int st = b / 1024, sb = b % 1024, swz = sb ^ (((sb >> 9) & 1) << 5); R = (st >> 1) * 16 + swz / 64; Cc = (st & 1) * 32 + (swz % 64) / 2; }
struct GUnit { const char* a0; const char* a1; const char* b0; const char* b1; int x0, x1, x2, x3; };

template <bool GATHER, class Sched, class Epi>
__device__ __forceinline__ void gemm_phase(LAS unsigned char* lds, const int wave_, const int K, const Sched& S, const Epi& E) {
    int tid = (wave_ << 6) | lane_id_(); asm volatile("" : "+v"(tid));
    const int wid = __builtin_amdgcn_readfirstlane(tid >> 6), lane = tid & 63, wr = wid >> 2, wc = wid & 3, fr = lane & 15, fq = lane >> 4;
    const int nt = K / BK;
    unsigned voff[2]; int RR[2], CC[2];
#pragma unroll
    for (int i = 0; i < 2; ++i) { stage_rc(tid * 16 + i * 8192, RR[i], CC[i]); RR[i] = (RR[i] & ~31) + perm32(RR[i] & 31); voff[i] = (unsigned)(RR[i] * K + CC[i]) * 2u; }
    const size_t kstep = (size_t)(BK * 2);
    const unsigned ldsw = (unsigned)wid * 1024u;
    const int aoff = lds_byte(wr * 64 + fr, fq * 8), boff = lds_byte(wc * 32 + fr, fq * 8);
#define PG8_SA(b, h) (((b) * 2 + (h)) * pg8::HTB)
#define PG8_SB(b, h) ((4 + (b) * 2 + (h)) * pg8::HTB)
#define PG8_STG(bufoff, gbase, o0, o1) do { \
        __builtin_amdgcn_global_load_lds((const unsigned*)((const char*)(gbase) + (o0)), (LAS unsigned*)(lds + (bufoff) + ldsw), 16, 0, 0); \
        __builtin_amdgcn_global_load_lds((const unsigned*)((const char*)(gbase) + (o1)), (LAS unsigned*)(lds + (bufoff) + ldsw + 8192), 16, 0, 0); } while (0)
#define PG8_LDA(dst, b, h) do { _Pragma("unroll") for (int m = 0; m < 4; ++m) _Pragma("unroll") for (int k = 0; k < 2; ++k) dst[m][k] = *(const LAS bf16x8*)(lds + PG8_SA(b, h) + aoff + m * 2048 + k * 1024); } while (0)
#define PG8_LDB(dst, b, h) do { _Pragma("unroll") for (int n = 0; n < 2; ++n) _Pragma("unroll") for (int k = 0; k < 2; ++k) dst[n][k] = *(const LAS bf16x8*)(lds + PG8_SB(b, h) + boff + n * 2048 + k * 1024); } while (0)
#define PG8_MMA(ai, bj, At, Bt) do { __builtin_amdgcn_s_setprio(1); _Pragma("unroll") for (int m = 0; m < 4; ++m) _Pragma("unroll") for (int n = 0; n < 2; ++n) _Pragma("unroll") for (int k = 0; k < 2; ++k) \
        acc[ai][bj][m][n] = __builtin_amdgcn_mfma_f32_16x16x32_bf16(Bt[n][k], At[m][k], acc[ai][bj][m][n], 0, 0, 0); __builtin_amdgcn_s_setprio(0); } while (0)
#define PG8_WAIT_V(n) asm volatile("s_waitcnt vmcnt(" #n ")" ::: "memory")
#define PG8_WAIT_L(n) asm volatile("s_waitcnt lgkmcnt(" #n ")" ::: "memory")
#define PG8_BAR __builtin_amdgcn_s_barrier()
#define PG8_SCHED __builtin_amdgcn_sched_barrier(0)
    GUnit cur, nxt; int ui = 0;
    if (!S.next(0, cur)) return;
    Acc acc; acc_zero(acc);
    bf16x8 At[4][2], B0[2][2], B1[2][2];
    unsigned vA0[2] = {voff[0], voff[1]}, vA1[2] = {voff[0], voff[1]}, nA0[2] = {voff[0], voff[1]}, nA1[2] = {voff[0], voff[1]};
    if constexpr (GATHER) S.avoff(cur, RR, CC, vA0, vA1);
    PG8_STG(PG8_SB(0, 0), cur.b0, voff[0], voff[1]); PG8_STG(PG8_SB(0, 1), cur.b1, voff[0], voff[1]); PG8_STG(PG8_SA(0, 0), cur.a0, vA0[0], vA0[1]); PG8_STG(PG8_SA(0, 1), cur.a1, vA1[0], vA1[1]);
    if (wr == 1) PG8_BAR;
    PG8_WAIT_V(2); PG8_BAR;
    PG8_STG(PG8_SB(1, 0), cur.b0 + kstep, voff[0], voff[1]); PG8_STG(PG8_SA(1, 0), cur.a0 + kstep, vA0[0], vA0[1]); PG8_STG(PG8_SB(1, 1), cur.b1 + kstep, voff[0], voff[1]);
    PG8_WAIT_V(6); PG8_BAR;
    for (;;) {
        const bool has_next = S.next(ui + 1, nxt);
        if (!has_next) nxt = cur;
        if constexpr (GATHER) { if (has_next) S.avoff(nxt, RR, CC, nA0, nA1); else { nA0[0] = vA0[0]; nA0[1] = vA0[1]; nA1[0] = vA1[0]; nA1[1] = vA1[1]; } }
        for (int t = 0; t < nt; t += 2) {
            const bool last = (t == nt - 2);
            const char* a1h1 = cur.a1 + (size_t)(t + 1) * kstep;
            const char* a2h0 = last ? nxt.a0 : cur.a0 + (size_t)(t + 2) * kstep; const char* a2h1 = last ? nxt.a1 : cur.a1 + (size_t)(t + 2) * kstep;
            const char* b2h0 = last ? nxt.b0 : cur.b0 + (size_t)(t + 2) * kstep; const char* b2h1 = last ? nxt.b1 : cur.b1 + (size_t)(t + 2) * kstep;
            const char* a3h0 = a2h0 + kstep; const char* b3h0 = b2h0 + kstep; const char* b3h1 = b2h1 + kstep;
            unsigned w0[2], w1[2];
            if (GATHER) { w0[0] = last ? nA0[0] : vA0[0]; w0[1] = last ? nA0[1] : vA0[1]; w1[0] = last ? nA1[0] : vA1[0]; w1[1] = last ? nA1[1] : vA1[1]; }
            else { w0[0] = voff[0]; w0[1] = voff[1]; w1[0] = voff[0]; w1[1] = voff[1]; }
            PG8_LDB(B0, 0, 0); PG8_LDB(B1, 0, 1); PG8_SCHED; PG8_LDA(At, 0, 0); PG8_STG(PG8_SA(1, 1), a1h1, vA1[0], vA1[1]);
            PG8_WAIT_V(8); PG8_WAIT_L(0); PG8_BAR; PG8_MMA(0, 0, At, B0); PG8_MMA(0, 1, At, B1); PG8_BAR; PG8_SCHED;
            PG8_LDA(At, 0, 1); PG8_STG(PG8_SB(0, 0), b2h0, voff[0], voff[1]); PG8_STG(PG8_SB(0, 1), b2h1, voff[0], voff[1]); PG8_STG(PG8_SA(0, 0), a2h0, w0[0], w0[1]);
            PG8_WAIT_V(8); PG8_WAIT_L(0); PG8_BAR; PG8_MMA(1, 0, At, B0); PG8_MMA(1, 1, At, B1); PG8_BAR; PG8_SCHED;
            PG8_LDB(B0, 1, 0); PG8_LDB(B1, 1, 1); PG8_SCHED; PG8_LDA(At, 1, 0); PG8_STG(PG8_SA(0, 1), a2h1, w1[0], w1[1]);
            PG8_WAIT_V(8); PG8_WAIT_L(0); PG8_BAR; PG8_MMA(0, 0, At, B0); PG8_MMA(0, 1, At, B1); PG8_BAR; PG8_SCHED;
            PG8_LDA(At, 1, 1); PG8_STG(PG8_SB(1, 0), b3h0, voff[0], voff[1]); PG8_STG(PG8_SB(1, 1), b3h1, voff[0], voff[1]); PG8_STG(PG8_SA(1, 0), a3h0, w0[0], w0[1]);
            PG8_WAIT_V(8); PG8_WAIT_L(0); PG8_BAR; PG8_MMA(1, 0, At, B0); PG8_MMA(1, 1, At, B1); PG8_BAR; PG8_SCHED;
        }
        if (wr == 0) PG8_BAR;
        E(acc, cur, wr, wc, fr, fq);
        if (!has_next) break;
        acc_zero(acc);
        cur = nxt; ++ui;
        if (GATHER) { vA0[0] = nA0[0]; vA0[1] = nA0[1]; vA1[0] = nA1[0]; vA1[1] = nA1[1]; }
        if (wr == 1) PG8_BAR;
    }
    PG8_WAIT_V(0);
    PG8_BAR;
#undef PG8_SA
#undef PG8_SB
#undef PG8_STG
#undef PG8_LDA
#undef PG8_LDB
#undef PG8_MMA
#undef PG8_WAIT_V
#undef PG8_WAIT_L
#undef PG8_BAR
#undef PG8_SCHED
}
}


namespace pg8 {
struct SUnit { const char* a0; const char* a1; const char* b0; const char* b1; int x0, x1, x2, x3, flags; };
constexpr int SF_PITCH1 = 1, SF_CHAIN = 2, SF_GATHER = 4, SF_WAIT = 8, SF_PUBLISH = 16;

template <class Sched, class Epi>
__device__ __forceinline__ void gemm_stream(LAS unsigned char* lds, const int wave_, const int pitch0, const int pitch1, const Sched& S, const Epi& E) {
    int tid = (wave_ << 6) | lane_id_(); asm volatile("" : "+v"(tid));
    const int wid = __builtin_amdgcn_readfirstlane(tid >> 6), lane = tid & 63, wr = wid >> 2, wc = wid & 3, fr = lane & 15, fq = lane >> 4;
    constexpr int nt = 8;
    int RR[2], CC[2];
#pragma unroll
    for (int i = 0; i < 2; ++i) { stage_rc(tid * 16 + i * 8192, RR[i], CC[i]); RR[i] = (RR[i] & ~31) + perm32(RR[i] & 31); }
    const size_t kstep = (size_t)(BK * 2);
    const unsigned ldsw = (unsigned)wid * 1024u;
    const int aoff = lds_byte(wr * 64 + fr, fq * 8), boff = lds_byte(wc * 32 + fr, fq * 8);
#define PG8_SA(b, h) (((b) * 2 + (h)) * pg8::HTB)
#define PG8_SB(b, h) ((4 + (b) * 2 + (h)) * pg8::HTB)
#define PG8_STG(bufoff, gbase, o0, o1) do { \
        __builtin_amdgcn_global_load_lds((const unsigned*)((const char*)(gbase) + (o0)), (LAS unsigned*)(lds + (bufoff) + ldsw), 16, 0, 0); \
        __builtin_amdgcn_global_load_lds((const unsigned*)((const char*)(gbase) + (o1)), (LAS unsigned*)(lds + (bufoff) + ldsw + 8192), 16, 0, 0); } while (0)
#define PG8_LDA(dst, b, h) do { _Pragma("unroll") for (int m = 0; m < 4; ++m) _Pragma("unroll") for (int k = 0; k < 2; ++k) dst[m][k] = *(const LAS bf16x8*)(lds + PG8_SA(b, h) + aoff + m * 2048 + k * 1024); } while (0)
#define PG8_LDB(dst, b, h) do { _Pragma("unroll") for (int n = 0; n < 2; ++n) _Pragma("unroll") for (int k = 0; k < 2; ++k) dst[n][k] = *(const LAS bf16x8*)(lds + PG8_SB(b, h) + boff + n * 2048 + k * 1024); } while (0)
#define PG8_MMA(ai, bj, At, Bt) do { __builtin_amdgcn_s_setprio(1); _Pragma("unroll") for (int m = 0; m < 4; ++m) _Pragma("unroll") for (int n = 0; n < 2; ++n) _Pragma("unroll") for (int k = 0; k < 2; ++k) \
        acc[ai][bj][m][n] = __builtin_amdgcn_mfma_f32_16x16x32_bf16(Bt[n][k], At[m][k], acc[ai][bj][m][n], 0, 0, 0); __builtin_amdgcn_s_setprio(0); } while (0)
#define PG8_WAIT_V(n) asm volatile("s_waitcnt vmcnt(" #n ")" ::: "memory")
#define PG8_WAIT_L(n) asm volatile("s_waitcnt lgkmcnt(" #n ")" ::: "memory")
#define PG8_BAR __builtin_amdgcn_s_barrier()
#define PG8_SCHED __builtin_amdgcn_sched_barrier(0)
#define PG8_OFFS(u, vB, vA0_, vA1_) do { const int pit_ = ((u).flags & SF_PITCH1) ? pitch1 : pitch0; vB[0] = (unsigned)(RR[0] * pit_ + CC[0]) * 2u; vB[1] = (unsigned)(RR[1] * pit_ + CC[1]) * 2u; \
        if ((u).flags & SF_GATHER) S.avoff((u), RR, CC, vA0_, vA1_); else { vA0_[0] = vB[0]; vA0_[1] = vB[1]; vA1_[0] = vB[0]; vA1_[1] = vB[1]; } } while (0)
    SUnit cur, nxt; int ui = 0;
    if (!S.next(0, cur)) return;
    Acc acc; acc_zero(acc);
    bf16x8 At[4][2], B0[2][2], B1[2][2];
    unsigned vB[2], vA0[2], vA1[2], nB[2], nA0[2], nA1[2];
    PG8_OFFS(cur, vB, vA0, vA1);
    S.a_ready(cur, wid);
    PG8_STG(PG8_SB(0, 0), cur.b0, vB[0], vB[1]); PG8_STG(PG8_SB(0, 1), cur.b1, vB[0], vB[1]); PG8_STG(PG8_SA(0, 0), cur.a0, vA0[0], vA0[1]); PG8_STG(PG8_SA(0, 1), cur.a1, vA1[0], vA1[1]);
    if (wr == 1) PG8_BAR;
    PG8_WAIT_V(2); PG8_BAR;
    PG8_STG(PG8_SB(1, 0), cur.b0 + kstep, vB[0], vB[1]); PG8_STG(PG8_SA(1, 0), cur.a0 + kstep, vA0[0], vA0[1]); PG8_STG(PG8_SB(1, 1), cur.b1 + kstep, vB[0], vB[1]);
    PG8_WAIT_V(6); PG8_BAR;
    for (;;) {
        const bool has_next = S.next(ui + 1, nxt);
        if (!has_next) { nxt = cur; nxt.flags &= ~(SF_WAIT); }
        PG8_OFFS(nxt, nB, nA0, nA1);
        for (int t = 0; t < nt; t += 2) {
            const bool last = (t == nt - 2);
            if (last && has_next) S.a_ready(nxt, wid);
            const char* a1h1 = cur.a1 + (size_t)(t + 1) * kstep;
            const char* a2h0 = last ? nxt.a0 : cur.a0 + (size_t)(t + 2) * kstep; const char* a2h1 = last ? nxt.a1 : cur.a1 + (size_t)(t + 2) * kstep;
            const char* b2h0 = last ? nxt.b0 : cur.b0 + (size_t)(t + 2) * kstep; const char* b2h1 = last ? nxt.b1 : cur.b1 + (size_t)(t + 2) * kstep;
            const char* a3h0 = a2h0 + kstep; const char* b3h0 = b2h0 + kstep; const char* b3h1 = b2h1 + kstep;
            unsigned w0[2], w1[2], wb[2];
            w0[0] = last ? nA0[0] : vA0[0]; w0[1] = last ? nA0[1] : vA0[1]; w1[0] = last ? nA1[0] : vA1[0]; w1[1] = last ? nA1[1] : vA1[1]; wb[0] = last ? nB[0] : vB[0]; wb[1] = last ? nB[1] : vB[1];
            PG8_LDB(B0, 0, 0); PG8_LDB(B1, 0, 1); PG8_SCHED; PG8_LDA(At, 0, 0); PG8_STG(PG8_SA(1, 1), a1h1, vA1[0], vA1[1]);
            PG8_WAIT_V(8); PG8_WAIT_L(0); PG8_BAR; PG8_MMA(0, 0, At, B0); PG8_MMA(0, 1, At, B1); PG8_BAR; PG8_SCHED;
            PG8_LDA(At, 0, 1); PG8_STG(PG8_SB(0, 0), b2h0, wb[0], wb[1]); PG8_STG(PG8_SB(0, 1), b2h1, wb[0], wb[1]); PG8_STG(PG8_SA(0, 0), a2h0, w0[0], w0[1]);
            PG8_WAIT_V(8); PG8_WAIT_L(0); PG8_BAR; PG8_MMA(1, 0, At, B0); PG8_MMA(1, 1, At, B1); PG8_BAR; PG8_SCHED;
            PG8_LDB(B0, 1, 0); PG8_LDB(B1, 1, 1); PG8_SCHED; PG8_LDA(At, 1, 0); PG8_STG(PG8_SA(0, 1), a2h1, w1[0], w1[1]);
            PG8_WAIT_V(8); PG8_WAIT_L(0); PG8_BAR; PG8_MMA(0, 0, At, B0); PG8_MMA(0, 1, At, B1); PG8_BAR; PG8_SCHED;
            PG8_LDA(At, 1, 1); PG8_STG(PG8_SB(1, 0), b3h0, wb[0], wb[1]); PG8_STG(PG8_SB(1, 1), b3h1, wb[0], wb[1]); PG8_STG(PG8_SA(1, 0), a3h0, w0[0], w0[1]);
            PG8_WAIT_V(8); PG8_WAIT_L(0); PG8_BAR; PG8_MMA(1, 0, At, B0); PG8_MMA(1, 1, At, B1); PG8_BAR; PG8_SCHED;
        }
        if (!(cur.flags & SF_CHAIN)) {
            if (wr == 0) PG8_BAR;
            E(acc, cur, wr, wc, fr, fq);
            S.done(cur, lane);
            if (has_next) { acc_zero(acc); if (wr == 1) PG8_BAR; }
        }
        if (!has_next) break;
        cur = nxt; ++ui;
        vB[0] = nB[0]; vB[1] = nB[1]; vA0[0] = nA0[0]; vA0[1] = nA0[1]; vA1[0] = nA1[0]; vA1[1] = nA1[1];
    }
    PG8_WAIT_V(0);
    PG8_BAR;
#undef PG8_OFFS
#undef PG8_SA
#undef PG8_SB
#undef PG8_STG
#undef PG8_LDA
#undef PG8_LDB
#undef PG8_MMA
#undef PG8_WAIT_V
#undef PG8_WAIT_L
#undef PG8_BAR
#undef PG8_SCHED
}
}

template <int STAGE>
__device__ __forceinline__ void p0_item(f32x4 (&v)[16], const float* W, int ldw, int s0, int s1, int k0, bf16_t* dst, int v0, int dpitch, const float* gain, LAS float* scr, int lane, const float cs = 1.0f) {
    const int c4 = lane & 15, rq = lane >> 4;
    if (STAGE == 0) {
        const int scol = ((c4 < 8) ? s0 : s1) + (c4 & 7) * 4;
#pragma unroll
        for (int i = 0; i < 16; ++i) v[i] = *(const f32x4*)(W + (size_t)(k0 + 4 * i + rq) * ldw + scol);
        return;
    }
    if (gain) {
#pragma unroll
        for (int i = 0; i < 16; ++i) v[i] = v[i] * gain[k0 + 4 * i + rq];
    }
    if (cs != 1.0f) {
#pragma unroll
        for (int i = 0; i < 16; ++i) v[i] = v[i] * cs;
    }
#pragma unroll
    for (int hlf = 0; hlf < 2; ++hlf) {
#pragma unroll
        for (int i = 0; i < 8; ++i) { LAS float* p = scr + (4 * i + rq) * 65 + c4 * 4; const f32x4 x = v[8 * hlf + i]; p[0] = x.x; p[1] = x.y; p[2] = x.z; p[3] = x.w; }
        asm volatile("s_waitcnt lgkmcnt(0)" ::: "memory");
        const int c = lane & 3;
#pragma unroll
        for (int j = 0; j < 4; ++j) { const int n = (lane >> 2) + 16 * j; const LAS float* s = scr + (8 * c) * 65 + n;
            u32x4 o; o.x = pk2(s[0 * 65], s[1 * 65]); o.y = pk2(s[2 * 65], s[3 * 65]); o.z = pk2(s[4 * 65], s[5 * 65]); o.w = pk2(s[6 * 65], s[7 * 65]);
            *(u32x4*)(dst + (size_t)(v0 + n) * dpitch + k0 + 32 * hlf + 8 * c) = o; EPI_FENCE(); }
        asm volatile("s_waitcnt lgkmcnt(0)" ::: "memory");
    }
}
constexpr int I_W1 = 16 * 64, I_WV = 16 * 16, I_WF = 8 * 16, I_WM = 8 * 16, I_WO = 16 * 16, I_WPG = 16 * 16, I_WPP = 4 * 16, I_GU = 32 * 16 * 8, I_D = 32 * 8 * 16;
constexpr int P0_NIT = I_W1 + I_WV + I_WF + I_WM + I_WO + I_WPG + I_WPP + 2 * I_GU + I_D, P0_EARLY = I_W1 + I_WV;
constexpr int CONV_CHUNK = 64, N_CONV_CHUNKS = (P0_NIT - P0_EARLY + CONV_CHUNK - 1) / CONV_CHUNK;
static_assert(10 * N_CONV_CHUNKS >= 2048, "the interleaved attention queue must cover all 2048 attention units");
template <int STAGE>
__device__ __forceinline__ void p0_weight_item(f32x4 (&v)[16], const Args& a, int it, LAS float* scr, int lane) {
    unsigned char* ws = a.ws;
            int r = it;
            if (r < I_W1) { const int kb = r >> 6, nb = r & 63, v0 = nb * 64; int s0, s1;
                if (v0 < 1024) { s0 = v0; s1 = v0 + 32; }
                else if (v0 < 2048) { const int u = v0 - 1024, sec = u >> 9, uu = u & 511, tile = uu >> 8, w = uu & 255, bj = w >> 7, u2 = w & 127;
                    s0 = 1536 + sec * 512 + tile * 256 + (u2 >> 5) * 64 + bj * 32; s1 = s0 + 64; }
                else if (v0 < 3072) { s0 = 3080 + (v0 - 2048); s1 = s0 + 32; }
                else { s0 = 4104 + (v0 - 3072); s1 = s0 + 32; }
                p0_item<STAGE>(v, a.in[3], INC, s0, s1, kb * 64, (bf16_t*)(ws + WS_W1), v0, 1024, nullptr, scr, lane, v0 >= 2048 ? -1.4426950408889634f : 1.0f); return; } r -= I_W1;
            if (r < I_WV) { const int kb = r >> 4, nb = r & 15, v0 = nb * 64; const int s0 = (v0 < 512) ? (1024 + v0) : (2560 + (v0 - 512));
                p0_item<STAGE>(v, a.in[3], INC, s0, s0 + 32, kb * 64, (bf16_t*)(ws + WS_WV), v0, 1024, nullptr, scr, lane); return; } r -= I_WV;
            if (r < I_WF) { const int kb = r >> 4, nb = r & 15; p0_item<STAGE>(v, a.in[5], 1024, nb * 64, nb * 64 + 32, kb * 64, (bf16_t*)(ws + WS_WF), nb * 64, 512, nullptr, scr, lane); return; } r -= I_WF;
            if (r < I_WM) { const int kb = r >> 4, nb = r & 15; p0_item<STAGE>(v, a.in[6], 1024, nb * 64, nb * 64 + 32, kb * 64, (bf16_t*)(ws + WS_WM), nb * 64, 512, nullptr, scr, lane); return; } r -= I_WM;
            if (r < I_WO) { const int kb = r >> 4, nb = r & 15; p0_item<STAGE>(v, a.in[7], 1024, nb * 64, nb * 64 + 32, kb * 64, (bf16_t*)(ws + WS_WO), nb * 64, 1024, nullptr, scr, lane); return; } r -= I_WO;
            if (r < I_WPG) { const int kb = r >> 4, nb = r & 15; p0_item<STAGE>(v, a.in[17], 1024, nb * 64, nb * 64 + 32, kb * 64, (bf16_t*)(ws + WS_WPG), nb * 64, 1024, a.in[16], scr, lane); return; } r -= I_WPG;
            if (r < I_WPP) { const int kb = r >> 4, nb = r & 15; p0_item<STAGE>(v, a.in[18], 1024, nb * 64, nb * 64 + 32, kb * 64, (bf16_t*)(ws + WS_WPP), nb * 64, 256, nullptr, scr, lane); return; } r -= I_WPP;
            if (r < I_GU) { const int e = r >> 7, q = r & 127, kb = q >> 3, nb = q & 7;
                p0_item<STAGE>(v, a.in[13] + (size_t)e * DM * DE, DE, nb * 64, nb * 64 + 32, kb * 64, (bf16_t*)(ws + WS_WG) + (size_t)e * DE * DM, nb * 64, 1024, a.in[8], scr, lane); return; } r -= I_GU;
            if (r < I_GU) { const int e = r >> 7, q = r & 127, kb = q >> 3, nb = q & 7;
                p0_item<STAGE>(v, a.in[14] + (size_t)e * DM * DE, DE, nb * 64, nb * 64 + 32, kb * 64, (bf16_t*)(ws + WS_WU) + (size_t)e * DE * DM, nb * 64, 1024, a.in[8], scr, lane); return; } r -= I_GU;
            { const int e = r >> 7, q = r & 127, kb = q >> 4, nb = q & 15;
                p0_item<STAGE>(v, a.in[15] + (size_t)e * DE * DM, DM, nb * 64, nb * 64 + 32, kb * 64, (bf16_t*)(ws + WS_WD) + (size_t)e * DM * DE, nb * 64, 512, nullptr, scr, lane); }
}


__device__ __forceinline__ void p0_weight_run(const Args& a, int it0, int step, int n, LAS float* scr, int lane) {
    f32x4 vA[16], vB[16];
    if (n > 0) p0_weight_item<0>(vA, a, it0, scr, lane);
    for (int i = 0; i < n; i += 2) {
        if (i + 1 < n) p0_weight_item<0>(vB, a, it0 + (i + 1) * step, scr, lane);
        p0_weight_item<1>(vA, a, it0 + i * step, scr, lane);
        if (i + 1 < n) { if (i + 2 < n) p0_weight_item<0>(vA, a, it0 + (i + 2) * step, scr, lane); p0_weight_item<1>(vB, a, it0 + (i + 1) * step, scr, lane); }
    }
}

__device__ __forceinline__ void phase0(const Ctx& C, const Args& a) {
    const int tid_ = opaque_tid(C), lane_ = tid_ & 63;
    unsigned char* ws = a.ws;
    const int gw = C.vcu * 8 + C.wave, NGW = C.G * 8;
    LAS float* wfl = (LAS float*)(C.lds + 73728);
    for (int idx = tid_; idx < 8192; idx += 512) { const int k = idx >> 3, c = idx & 7; wfl[c * 1024 + k] = a.in[3][(size_t)k * INC + 3072 + c]; }
    __syncthreads();
    {
        const float* g = a.in[2]; const float* bfg = a.in[4];
        bf16_t* HB = (bf16_t*)(ws + WS_HB); float* LOGF = (float*)(ws + WS_LOGF);
        f32x4 gv[4];
#pragma unroll
        for (int j = 0; j < 4; ++j) gv[j] = *(const f32x4*)(g + 4 * lane_ + 256 * j);
        f32x4 vn[4];
        if (gw < T) {
#pragma unroll
            for (int j = 0; j < 4; ++j) vn[j] = ((const f32x4*)(a.in[0] + (size_t)gw * DM) + lane_)[64 * j]; }
        for (int t = gw; t < T; t += NGW) {
            f32x4 v[4]; float ss = 0.f;
#pragma unroll
            for (int j = 0; j < 4; ++j) v[j] = vn[j];
            if (t + NGW < T) {
#pragma unroll
                for (int j = 0; j < 4; ++j) vn[j] = ((const f32x4*)(a.in[0] + (size_t)(t + NGW) * DM) + lane_)[64 * j]; }
#pragma unroll
            for (int j = 0; j < 4; ++j) ss += (v[j].x * v[j].x + v[j].y * v[j].y) + (v[j].z * v[j].z + v[j].w * v[j].w);
            const float rstd = 1.0f / sqrtf(wave_sum(ss) * (1.0f / DM) + RMS_EPS);
            unsigned long long* o8 = (unsigned long long*)(HB + (size_t)t * DM) + lane_;
#pragma unroll
            for (int j = 0; j < 4; ++j) { v[j] = v[j] * rstd * gv[j]; o8[64 * j] = (unsigned long long)pk2(v[j].x, v[j].y) | ((unsigned long long)pk2(v[j].z, v[j].w) << 32); }
            float fl[8];
#pragma unroll
            for (int c = 0; c < 8; ++c) { float s = 0.f;
#pragma unroll
                for (int j = 0; j < 4; ++j) { const f32x4 w = *(LAS const f32x4*)(wfl + c * 1024 + 4 * lane_ + 256 * j); s += (v[j].x * w.x + v[j].y * w.y) + (v[j].z * w.z + v[j].w * w.w); }
                fl[c] = wave_sum(s); }
            if (lane_ < 8) {
                float z = 0.f;
#pragma unroll
                for (int c = 0; c < 8; ++c) z = (lane_ == c) ? fl[c] : z;
                z += bfg[lane_];
                const float ls = (z >= 0.f) ? -log1pf(expf(-z)) : (z - log1pf(expf(z)));
                const int b = t >> 12, s_ = t & 4095;
                LOGF[(size_t)(b * 8 + lane_) * SEQ + s_] = ls;
            }
        }
    }
    {
        float* COS = (float*)(ws + WS_COS); float* SIN = (float*)(ws + WS_SIN);
        for (int idx = C.vcu * 512 + tid_; idx < SEQ * 32; idx += C.G * 512) {
            const int pos = idx >> 5, i = idx & 31;
            const double inv = exp(-(double)i * (1.0 / 32.0) * 9.210340371976184);
            const double ang = (double)pos * inv;
            double sn, cs; sincos(ang, &sn, &cs);
            COS[idx] = (float)cs; SIN[idx] = (float)sn;
        }
    }
    {
        bf16_t* WRH = (bf16_t*)(ws + WS_WRH); bf16_t* WRL = (bf16_t*)(ws + WS_WRL);
        for (int idx = C.vcu * 512 + tid_; idx < 32 * 3 * 64 * 8; idx += C.G * 512) {
            const int j = idx & 7, ln = (idx >> 3) & 63, nf = (idx >> 9) % 3, ks = (idx >> 9) / 3;
            const int n = 16 * nf + (ln & 15), k = 32 * ks + 8 * (ln >> 4) + j;
            float v = 0.f;
            if (n < 4) v = a.in[9][k * 4 + n]; else if (n < 36) v = a.in[11][k * 32 + (n - 4)];
            v *= a.in[8][k];
            const unsigned h = pk2(v, 0.f) & 0xffffu; const float hf = __builtin_bit_cast(float, h << 16);
            WRH[idx] = (bf16_t)h; WRL[idx] = (bf16_t)(pk2(v - hf, 0.f) & 0xffffu);
        }
    }
    {
        LAS float* scr = (LAS float*)(C.lds + C.wave * 8704);
        { const int gw2 = C.wave * C.G + C.vcu;
          const int n = (gw2 < P0_EARLY) ? (P0_EARLY - gw2 + NGW - 1) / NGW : 0; p0_weight_run(a, gw2, NGW, n, scr, lane_); }
    }
}

__device__ __forceinline__ void p1_cumsum(const Ctx& C, const Args& a) {
    const int tid_ = opaque_tid(C), lane_ = tid_ & 63;
    if (C.vcu < 64) {
        const float* LOGF = (const float*)(a.ws + WS_LOGF) + (size_t)C.vcu * SEQ; float* C2 = (float*)(a.ws + WS_C2) + (size_t)C.vcu * SEQ;
        LAS double* wsum = (LAS double*)(C.lds);
        const f32x4 v0 = *(const f32x4*)(LOGF + 8 * tid_), v1 = *(const f32x4*)(LOGF + 8 * tid_ + 4);
        const double e[8] = {(double)v0.x, (double)v0.y, (double)v0.z, (double)v0.w, (double)v1.x, (double)v1.y, (double)v1.z, (double)v1.w};
        double loc = 0.0;
#pragma unroll
        for (int i = 0; i < 8; ++i) loc += e[i];
        double inc = loc;
#pragma unroll
        for (int o = 1; o < 64; o <<= 1) { const double nb = __shfl_up(inc, o); if (lane_ >= o) inc += nb; }
        if (lane_ == 63) wsum[C.wave] = inc;
        __syncthreads();
        double run = inc - loc;
        for (int w = 0; w < C.wave; ++w) run += wsum[w];
        float o8[8];
#pragma unroll
        for (int i = 0; i < 8; ++i) { run += e[i]; o8[i] = (float)(run * 1.4426950408889634); }
        *(f32x4*)(C2 + 8 * tid_) = (f32x4){o8[0], o8[1], o8[2], o8[3]}; *(f32x4*)(C2 + 8 * tid_ + 4) = (f32x4){o8[4], o8[5], o8[6], o8[7]};
        __syncthreads();
    }
}

template <bool ISK>
__device__ __forceinline__ void rope_epi(unsigned char* ws, Acc& acc, int pm, int pn, int rowt, int wr, int wc, int fr, int fq) {
    bf16_t* O = (bf16_t*)(ws + (ISK ? WS_KM : WS_QM)); const float sc = ISK ? 1.0f : QSCALE;
    const float* COS = (const float*)(ws + WS_COS); const float* SIN = (const float*)(ws + WS_SIN);
    const int head = 4 * (pn & 1) + wc;
    f32x4 cs1[2] = {{0.f, 0.f, 0.f, 0.f}, {0.f, 0.f, 0.f, 0.f}}, cs2[2] = {{0.f, 0.f, 0.f, 0.f}, {0.f, 0.f, 0.f, 0.f}};
#pragma unroll
    for (int ai = 0; ai < 2; ++ai)
#pragma unroll
        for (int m = 0; m < 4; ++m) { const int row = rowt + 128 * ai + RL(m, fr); const int pos = row & (SEQ - 1);
            bf16_t* rp = O + ((size_t)((row >> 12) * 8 + head) * SEQ + pos) * 64 + 8 * fq;
            u32x4 lo4, hi4;
#pragma unroll
            for (int n = 0; n < 2; ++n) { const f32x4 co = *(const f32x4*)(COS + pos * 32 + 4 * n + 8 * fq), si = *(const f32x4*)(SIN + pos * 32 + 4 * n + 8 * fq);
                const f32x4 x1 = acc[ai][0][m][n], x2 = acc[ai][1][m][n];
                const f32x4 o1 = x1 * co - x2 * si, o2 = x2 * co + x1 * si;
                if (ISK) { cs1[n] += o1; cs2[n] += o2; asm volatile("" : "+v"(cs1[n]), "+v"(cs2[n])); }
                const f32x4 w1 = o1 * sc, w2 = o2 * sc;
                lo4[2 * n] = pk2(w1.x, w1.y); lo4[2 * n + 1] = pk2(w1.z, w1.w); hi4[2 * n] = pk2(w2.x, w2.y); hi4[2 * n + 1] = pk2(w2.z, w2.w); }
            *(u32x4*)(rp) = lo4; *(u32x4*)(rp + 32) = hi4;
            EPI_FENCE(); }
    if (ISK) {
        float* KMP = (float*)(ws + WS_KMP) + (size_t)(pm * 2 + wr) * 512 + head * 64;
#pragma unroll
        for (int n = 0; n < 2; ++n)
#pragma unroll
            for (int j = 0; j < 4; ++j) { float v1 = cs1[n][j], v2 = cs2[n][j];
#pragma unroll
                for (int o = 1; o < 16; o <<= 1) { v1 += __shfl_xor(v1, o); v2 += __shfl_xor(v2, o); }
                if (fr == 0) { KMP[4 * n + 8 * fq + j] = v1; KMP[32 + 4 * n + 8 * fq + j] = v2; }
                EPI_FENCE(); }
    }
}

__device__ __forceinline__ void p1_epi_proj(unsigned char* ws, Acc& acc, int pm, int pn, int wr, int wc, int fr, int fq) {
    const int lane = fr + 16 * fq;
    const int rowt = pm * 256 + 64 * wr;
    if (pn < 4) {
        bf16_t* O = (bf16_t*)(ws + (pn < 2 ? WS_QF : WS_KF)); const float sc = (pn < 2) ? QSCALE : 1.0f; const int cb = (pn & 1) * 256 + 32 * wc + 8 * fq;
#pragma unroll
        for (int ai = 0; ai < 2; ++ai)
#pragma unroll
            for (int m = 0; m < 4; ++m) { const int row = rowt + 128 * ai + RL(m, fr);
#pragma unroll
                for (int bj = 0; bj < 2; ++bj) { bf16_t* rp = O + ((size_t)((row >> 12) * 8 + 4 * (pn & 1) + 2 * bj + (wc >> 1)) * SEQ + (row & (SEQ - 1))) * 64 + 32 * (wc & 1) + 8 * fq;
#pragma unroll
                    for (int n = 0; n < 2; ++n) { const f32x4 v = acc[ai][bj][m][n] * sc; *(u32x2*)(rp + 4 * n) = (u32x2){pk2(v.x, v.y), pk2(v.z, v.w)}; } } EPI_FENCE(); }
        if (pn >= 2) {
            unsigned* KMX = (unsigned*)(ws + WS_CTL) + CW_KMAX;
#pragma unroll
            for (int bj = 0; bj < 2; ++bj) { float mx = 0.f;
#pragma unroll
                for (int ai = 0; ai < 2; ++ai)
#pragma unroll
                    for (int m = 0; m < 4; ++m) { const f32x4 u = acc[ai][bj][m][0], w = acc[ai][bj][m][1];
                        float ssq = (u.x * u.x + u.y * u.y) + (u.z * u.z + u.w * u.w) + (w.x * w.x + w.y * w.y) + (w.z * w.z + w.w * w.w);
                        ssq += __shfl_xor(ssq, 16); ssq += __shfl_xor(ssq, 32); mx = fmaxf(mx, ssq); }
#pragma unroll
                for (int o = 1; o < 16; o <<= 1) mx = fmaxf(mx, __shfl_xor(mx, o));
                if (lane == 0) atomicMax(KMX + 64 * (((pm >> 4) * 8 + 4 * (pn & 1) + 2 * bj + (wc >> 1)) * 2 + (wc & 1)), __float_as_uint(mx));
                EPI_FENCE(); }
        }
    } else if (pn < 6) { rope_epi<false>(ws, acc, pm, pn, rowt, wr, wc, fr, fq);
    } else if (pn < 8) { rope_epi<true>(ws, acc, pm, pn, rowt, wr, wc, fr, fq);
    } else {
        bf16_t* O = (bf16_t*)(ws + (pn < 12 ? WS_SA : WS_SB)); const int cb = ((pn - 8) & 3) * 256 + 32 * wc + 8 * fq;
#pragma unroll
        for (int ai = 0; ai < 2; ++ai)
#pragma unroll
            for (int m = 0; m < 4; ++m) { bf16_t* rp = O + (size_t)(rowt + 128 * ai + RL(m, fr)) * DM + cb;
#pragma unroll
                for (int bj = 0; bj < 2; ++bj)
#pragma unroll
                    for (int n = 0; n < 2; ++n) { const f32x4 v = acc[ai][bj][m][n];
                        *(u32x2*)(rp + 128 * bj + 4 * n) = (u32x2){pk2(v.x, v.y), pk2(v.z, v.w)}; } EPI_FENCE(); }
    }
}
__device__ __forceinline__ void p1_epi_vt(unsigned char* ws, Acc& acc, int pmf, int pnt, int wr, int wc, int fr, int fq) {
    bf16_t* VT = (bf16_t*)(ws + WS_VT);
    const int tok0 = pnt * 256, b = tok0 >> 12, s0 = (tok0 & (SEQ - 1)) + 32 * wc + 8 * fq;
#pragma unroll
    for (int ai = 0; ai < 2; ++ai)
#pragma unroll
        for (int m = 0; m < 4; ++m) { const int f = pmf * 256 + 128 * ai + 64 * wr + RL(m, fr); const int type = f >> 9, hh = (f >> 6) & 7, d = f & 63;
            bf16_t* rp = VT + (size_t)((type * 8 + b) * 8 + hh) * 64 * SEQ + d * 64;
#pragma unroll
            for (int bj = 0; bj < 2; ++bj)
                { const f32x4 v = acc[ai][bj][m][0], w = acc[ai][bj][m][1]; const int s = s0 + 128 * bj;
                  *(u32x4*)(rp + (size_t)(s >> 6) * 4096 + (s & 63)) = (u32x4){pk2(v.x, v.y), pk2(v.z, v.w), pk2(w.x, w.y), pk2(w.z, w.w)}; } EPI_FENCE(); }
}

struct P1Sched {
    const char* H; const char* W1; const char* WV; int vcu, G;
    __device__ __forceinline__ bool next(int i, pg8::GUnit& u) const {
        const int L = i * G + vcu; if (L >= 2560) return false;
        if (L < 2048) { const int pm = L >> 4, pn = (L + ((G & 15) ? 0 : 2 * i)) & 15; u.x0 = pm; u.x1 = pn; u.x2 = 0; u.x3 = 0;
            u.a0 = H + (size_t)pm * 256 * 2048; u.a1 = u.a0 + (size_t)128 * 2048; u.b0 = W1 + (size_t)pn * 256 * 2048; u.b1 = u.b0 + (size_t)128 * 2048; }
        else { const int Lv = L - 2048, pmf = Lv & 3, pnt = Lv >> 2; u.x0 = pmf; u.x1 = pnt; u.x2 = 1; u.x3 = 0;
            u.a0 = WV + (size_t)pmf * 256 * 2048; u.a1 = u.a0 + (size_t)128 * 2048; u.b0 = H + (size_t)pnt * 256 * 2048; u.b1 = u.b0 + (size_t)128 * 2048; }
        return true; }
};
struct P1Epi {
    unsigned char* ws;
    __device__ __forceinline__ void operator()(Acc& acc, const pg8::GUnit& u, int wr, int wc, int fr, int fq) const {
        if (u.x2 == 0) p1_epi_proj(ws, acc, u.x0, u.x1, wr, wc, fr, fq); else p1_epi_vt(ws, acc, u.x0, u.x1, wr, wc, fr, fq); }
};

constexpr int AL_K = 0, AL_V = 16384, AL_C = 42496, AL_VOTE = 43008, AL_V_STRIDE = 136, AL_VB = 8704;
template <bool LAG, int type>
__device__ __forceinline__ void attn_tile(LAS unsigned char* L, const int t, const int kv0, const int q0, const int qpos, const int q32, const int hi, const int qb, const unsigned sel,
                                          const float base, const bf16x8 (&qf)[4], f32x16& negm, f32x16& o0, f32x16& o1, float& mref, f32x16& osum, bf16x8 (&pend)[2][2], int& tpend, f32x16& cinp, int& cin_blk) {
    const int kroff = q32 * 128, ksw = (q32 >> 1) & 7; const int cur = t & 1;
    const short one_ = (q32 == 0) ? (short)0x3F80 : (short)0; const bf16x8 vones = {one_, one_, one_, one_, one_, one_, one_, one_};
    if (LAG && tpend >= 0) {
        LAS const unsigned char* Vp = L + AL_V + (tpend % 3) * AL_VB;
        bf16x8 wfa[2][2], wfc[2][2];
#pragma unroll
        for (int blk = 0; blk < 2; ++blk)
#pragma unroll
            for (int s = 0; s < 2; ++s) {
                LAS const unsigned char* vp = Vp + q32 * AL_V_STRIDE + (32 * blk + 16 * s + 4 * hi) * 2;
                const s16x4 a0 = *(LAS const s16x4*)(vp), a1 = *(LAS const s16x4*)(vp + 16);
                const s16x4 c0 = *(LAS const s16x4*)(vp + 32 * AL_V_STRIDE), c1 = *(LAS const s16x4*)(vp + 32 * AL_V_STRIDE + 16);
                wfa[blk][s] = (bf16x8){a0[0], a0[1], a0[2], a0[3], a1[0], a1[1], a1[2], a1[3]};
                wfc[blk][s] = (bf16x8){c0[0], c0[1], c0[2], c0[3], c1[0], c1[1], c1[2], c1[3]};
            }
        __builtin_amdgcn_sched_barrier(0);
#pragma unroll
        for (int blk = 0; blk < 2; ++blk)
#pragma unroll
            for (int s = 0; s < 2; ++s) {
                o0 = __builtin_amdgcn_mfma_f32_32x32x16_bf16(wfa[blk][s], pend[blk][s], o0, 0, 0, 0);
                o1 = __builtin_amdgcn_mfma_f32_32x32x16_bf16(wfc[blk][s], pend[blk][s], o1, 0, 0, 0);
                osum = __builtin_amdgcn_mfma_f32_32x32x16_bf16(vones, pend[blk][s], osum, 0, 0, 0);
            }
        tpend = -1;
    }
        if (kv0 <= q0 + 31) {
            LAS const unsigned char* Kb = L + AL_K + cur * 8192; LAS const unsigned char* Vb = L + AL_V + (t % 3) * AL_VB; LAS const float* Cb = (LAS const float*)(L + AL_C + cur * 256);
            const int nblk = kv0 >> 8;
            const bool unsel = (type == 1) && (nblk < qb) && !((sel >> nblk) & 1u);
            if (type == 1 && cin_blk != nblk) { cin_blk = nblk;
#pragma unroll
                for (int r = 0; r < 16; ++r) cinp[r] = unsel ? -INFINITY : negm[r]; }
            const f32x16 cin = (type == 1) ? cinp : negm;
            f32x16 p0, p1;
#pragma unroll
            for (int kh = 0; kh < 2; ++kh) {
                bf16x8 kfa[2], kfb[2];
#pragma unroll
                for (int k2 = 0; k2 < 2; ++k2) { const int ks = 2 * kh + k2; kfa[k2] = *(LAS const bf16x8*)(Kb + kroff + (((2 * ks + hi) ^ ksw) * 16)); kfb[k2] = *(LAS const bf16x8*)(Kb + 4096 + kroff + (((2 * ks + hi) ^ ksw) * 16)); }
                __builtin_amdgcn_sched_barrier(0);
#pragma unroll
                for (int k2 = 0; k2 < 2; ++k2) { const int ks = 2 * kh + k2;
                    p0 = __builtin_amdgcn_mfma_f32_32x32x16_bf16(kfa[k2], qf[ks], ks == 0 ? cin : p0, 0, 0, 0);
                    p1 = __builtin_amdgcn_mfma_f32_32x32x16_bf16(kfb[k2], qf[ks], ks == 0 ? cin : p1, 0, 0, 0); }
                __builtin_amdgcn_sched_barrier(0);
            }
            bf16x8 vfa[2][2], vfc[2][2];
            if (!LAG)
#pragma unroll
            for (int blk = 0; blk < 2; ++blk)
#pragma unroll
                for (int s = 0; s < 2; ++s) {
                    LAS const unsigned char* vp = Vb + q32 * AL_V_STRIDE + (32 * blk + 16 * s + 4 * hi) * 2;
                    const s16x4 a0 = *(LAS const s16x4*)(vp), a1 = *(LAS const s16x4*)(vp + 16);
                    const s16x4 c0 = *(LAS const s16x4*)(vp + 32 * AL_V_STRIDE), c1 = *(LAS const s16x4*)(vp + 32 * AL_V_STRIDE + 16);
                    vfa[blk][s] = (bf16x8){a0[0], a0[1], a0[2], a0[3], a1[0], a1[1], a1[2], a1[3]};
                    vfc[blk][s] = (bf16x8){c0[0], c0[1], c0[2], c0[3], c1[0], c1[1], c1[2], c1[3]};
                }
            __builtin_amdgcn_sched_barrier(0);
            if (type == 0) {
#pragma unroll
                for (int gh = 0; gh < 2; ++gh) {
#pragma unroll
                    for (int g2 = 0; g2 < 2; ++g2) { const int g = 2 * gh + g2; const f32x4 c0 = *(LAS const f32x4*)(Cb + 8 * g + 4 * hi), c1 = *(LAS const f32x4*)(Cb + 32 + 8 * g + 4 * hi);
#pragma unroll
                        for (int j = 0; j < 4; ++j) { p0[4 * g + j] -= c0[j]; p1[4 * g + j] -= c1[j]; } }
                    __builtin_amdgcn_sched_barrier(0); }
            }
            const bool diag = (kv0 + 63 > q0);
            if (diag) {
                int qp2 = qpos; asm volatile("" : "+v"(qp2));
#pragma unroll
                for (int r = 0; r < 16; ++r) { const int kv = kv0 + (r & 3) + 8 * (r >> 2) + 4 * hi; if (kv > qp2) p0[r] = -INFINITY; if (kv + 32 > qp2) p1[r] = -INFINITY; }
            }
            float ra = __builtin_fmaxf(__builtin_fmaxf(p0[0], p0[1]), p0[2]), rb = __builtin_fmaxf(__builtin_fmaxf(p1[0], p1[1]), p1[2]);
#pragma unroll
            for (int r = 3; r < 15; r += 2) { ra = __builtin_fmaxf(__builtin_fmaxf(ra, p0[r]), p0[r + 1]); rb = __builtin_fmaxf(__builtin_fmaxf(rb, p1[r]), p1[r + 1]); }
            float rm = __builtin_fmaxf(__builtin_fmaxf(ra, rb), __builtin_fmaxf(p0[15], p1[15]));
            rm = xhalf_max(rm);
            if (__any(rm > 8.0f)) {
                const float d = __builtin_fmaxf(rm, 0.f);
                mref += d;
                const float alpha = __builtin_amdgcn_exp2f(-d);
                osum[0] *= alpha;
#pragma unroll
                for (int r = 0; r < 16; ++r) { p0[r] -= d; p1[r] -= d; o0[r] *= alpha; o1[r] *= alpha; negm[r] = base - mref; }
                cin_blk = -1;
            }
#pragma unroll
            for (int r = 0; r < 16; ++r) { p0[r] = __builtin_amdgcn_exp2f(p0[r]); p1[r] = __builtin_amdgcn_exp2f(p1[r]); }
            bf16x8 pb[2][2];
#pragma unroll
            for (int s = 0; s < 2; ++s) {
                u32x4 w0 = {pk2(p0[8 * s + 0], p0[8 * s + 1]), pk2(p0[8 * s + 2], p0[8 * s + 3]), pk2(p0[8 * s + 4], p0[8 * s + 5]), pk2(p0[8 * s + 6], p0[8 * s + 7])};
                u32x4 w1 = {pk2(p1[8 * s + 0], p1[8 * s + 1]), pk2(p1[8 * s + 2], p1[8 * s + 3]), pk2(p1[8 * s + 4], p1[8 * s + 5]), pk2(p1[8 * s + 6], p1[8 * s + 7])};
                pb[0][s] = __builtin_bit_cast(bf16x8, w0); pb[1][s] = __builtin_bit_cast(bf16x8, w1);
            }
            if (LAG) { pend[0][0] = pb[0][0]; pend[0][1] = pb[0][1]; pend[1][0] = pb[1][0]; pend[1][1] = pb[1][1]; tpend = t; }
            else {
#pragma unroll
            for (int blk = 0; blk < 2; ++blk)
#pragma unroll
                for (int s = 0; s < 2; ++s) {
                    o0 = __builtin_amdgcn_mfma_f32_32x32x16_bf16(vfa[blk][s], pb[blk][s], o0, 0, 0, 0);
                    o1 = __builtin_amdgcn_mfma_f32_32x32x16_bf16(vfc[blk][s], pb[blk][s], o1, 0, 0, 0);
                    osum = __builtin_amdgcn_mfma_f32_32x32x16_bf16(vones, pb[blk][s], osum, 0, 0, 0);
                }
            }
        }
}

template <bool LAG, int type>
__device__ __forceinline__ void attn_loop(LAS unsigned char* L, volatile LAS unsigned* VOTE, const int nt, const int tid, const int lane, const int wid, const int q0, const int qpos, const int q32, const int hi,
                                          const int qb, const unsigned sel, const float base, const float qkb, const bf16x8 (&qf)[4], const bf16_t* ksrc, const bf16_t* vsrc, const float* C2, const int kwoff, const int vwoff,
                                          u32x4 rk, u32x4 rv, float rc, f32x16& negm, f32x16& o0, f32x16& o1, float& mref, f32x16& osum) {
    bf16x8 pend[2][2]; int tpend = -1; f32x16 cinp = negm; int cin_blk = -1;
    const int tw = (q0 + 31) >> 6;
#pragma unroll
    for (int i_ = 0; i_ < 2; ++i_)
#pragma unroll
        for (int j_ = 0; j_ < 2; ++j_) pend[i_][j_] = (bf16x8){0, 0, 0, 0, 0, 0, 0, 0};
    for (int t = nt - 1; t >= 0; --t) {
        const int cur = t & 1;
        const int kv0 = t * 64;
        bool more = (t > 0);
        if (type == 0 && t < nt - 1 && more) {
            unsigned any = 0u;
#pragma unroll
            for (int w8 = 0; w8 < 8; ++w8) any |= VOTE[(((t + 1) & 1) * 8 + w8)];
            more = (any != 0u);
        }
        if (more) { rk = *(const u32x4*)(ksrc + (size_t)(t - 1) * 4096); rv = *(const u32x4*)(vsrc + (size_t)(t - 1) * 4096); if (type == 0 && tid < 64) rc = C2[kv0 - 64 + tid]; }
        attn_tile<LAG, type>(L, t, kv0, q0, qpos, q32, hi, qb, sel, base, qf, negm, o0, o1, mref, osum, pend, tpend, cinp, cin_blk);
        if (type == 0 && t >= 2) {
            const float clim = C2[(t - 1) * 64 - 1];
            const bool need = (t > tw) || !(qkb - clim < mref - 40.0f);
            const unsigned long long nb = __ballot(need);
            if (lane == 0) VOTE[(t & 1) * 8 + wid] = (nb != 0ull) ? 1u : 0u;
        }
        if (!more) break;
        {
            const int nx = cur ^ 1, vx = (t + 2) % 3;
            *(LAS u32x4*)(L + AL_K + nx * 8192 + kwoff) = rk;
            *(LAS u32x2*)(L + AL_V + vx * AL_VB + vwoff) = (u32x2){rv.x, rv.y}; *(LAS u32x2*)(L + AL_V + vx * AL_VB + vwoff + 8) = (u32x2){rv.z, rv.w};
            if (type == 0 && tid < 64) *(LAS float*)(L + AL_C + nx * 256 + tid * 4) = rc;
        }
        __syncthreads();
    }
    if (LAG && tpend >= 0) attn_tile<true, type>(L, -1, 1 << 30, q0, qpos, q32, hi, qb, sel, base, qf, negm, o0, o1, mref, osum, pend, tpend, cinp, cin_blk);
}


__device__ __forceinline__ void moba_select4(const Ctx& C, const Args& a, const int task0, const int tstep) {
    const int tid = opaque_tid(C), lane = tid & 63, q32 = lane & 31, hi = lane >> 5;
    unsigned char* ws = a.ws;
    LAS float* KMT = (LAS float*)C.lds;
    int qbk[4], bhk[4]; bf16x8 qf[4][4];
#pragma unroll
    for (int k = 0; k < 4; ++k) { const int task = task0 + k * tstep; const bool ok = task < 64 * 16 * 8;
        qbk[k] = ok ? (task >> 3) & 15 : 0; bhk[k] = ok ? task >> 7 : 0;
        const int b = bhk[k] >> 3, h = bhk[k] & 7;
        if (qbk[k] >= 4) {
            for (int i = tid; i < qbk[k] * 64; i += 512) { const int n = i >> 6, d = i & 63; const float* km0 = (const float*)(ws + WS_KMP) + (size_t)((b * 16 + n) * 2) * 512 + h * 64 + d; KMT[k * 1024 + i] = km0[0] + km0[512]; }
            const bf16_t* qp = (const bf16_t*)(ws + WS_QM) + ((size_t)bhk[k] * SEQ + qbk[k] * 256 + 32 * (task & 7) + q32) * 64 + hi * 8;
#pragma unroll
            for (int ks = 0; ks < 4; ++ks) qf[k][ks] = *(const bf16x8*)(qp + ks * 16);
        }
    }
    __syncthreads();
    unsigned pack[4];
#pragma unroll
    for (int k = 0; k < 4; ++k) { const int qb = qbk[k];
        if (qb <= 3) pack[k] = 0x210u | ((unsigned)qb << 12);
        else {
            float v1 = -INFINITY, v2 = -INFINITY, v3 = -INFINITY; int i1 = 0, i2 = 0, i3 = 0;
            for (int n = 0; n < qb; ++n) {
                LAS const float* km0 = KMT + k * 1024 + n * 64 + hi * 8;
                float g = 0.f;
#pragma unroll
                for (int ks = 0; ks < 4; ++ks) { const f32x4 ka = *(LAS const f32x4*)(km0 + ks * 16), kb = *(LAS const f32x4*)(km0 + ks * 16 + 4);
                    g += bf2f(qf[k][ks][0]) * ka.x + bf2f(qf[k][ks][1]) * ka.y + bf2f(qf[k][ks][2]) * ka.z + bf2f(qf[k][ks][3]) * ka.w
                       + bf2f(qf[k][ks][4]) * kb.x + bf2f(qf[k][ks][5]) * kb.y + bf2f(qf[k][ks][6]) * kb.z + bf2f(qf[k][ks][7]) * kb.w; }
                g = xhalf_sum(g);
                if (g > v1) { v3 = v2; i3 = i2; v2 = v1; i2 = i1; v1 = g; i1 = n; }
                else if (g > v2) { v3 = v2; i3 = i2; v2 = g; i2 = n; }
                else if (g > v3) { v3 = g; i3 = n; }
            }
            pack[k] = (unsigned)i1 | ((unsigned)i2 << 4) | ((unsigned)i3 << 8) | (3u << 12);
        }
    }
    unsigned mycnt[4], mybase[4];
#pragma unroll
    for (int k = 0; k < 4; ++k) { const unsigned ns = pack[k] >> 12; const int s0 = pack[k] & 15, s1 = (pack[k] >> 4) & 15, s2 = (pack[k] >> 8) & 15;
        mycnt[k] = 0u;
        for (int j = 0; j < qbk[k]; ++j) { const bool on = (hi == 0) && ((s0 == j) || (ns > 1u && s1 == j) || (ns > 2u && s2 == j));
            const unsigned long long m = __ballot(on); if (lane == j) mycnt[k] = (unsigned)__popcll(m); } }
#pragma unroll
    for (int k = 0; k < 4; ++k) { unsigned* LC = (unsigned*)(ws + WS_CTL) + CW_LCNT + 32 * (bhk[k] * 16);
        mybase[k] = 0u;
        if (lane < qbk[k] && mycnt[k] > 0u) mybase[k] = __hip_atomic_fetch_add(LC + 32 * lane, mycnt[k], __ATOMIC_RELAXED, __HIP_MEMORY_SCOPE_AGENT); }
#pragma unroll
    for (int k = 0; k < 4; ++k) { const unsigned ns = pack[k] >> 12; const int s0 = pack[k] & 15, s1 = (pack[k] >> 4) & 15, s2 = (pack[k] >> 8) & 15;
        const int qpos = qbk[k] * 256 + 32 * ((task0 + k * tstep) & 7) + q32;
        unsigned short* LIST = (unsigned short*)((unsigned char*)a.out + XS_LIST) + (size_t)(bhk[k] * 16) * LIST_CAP;
        for (int j = 0; j < qbk[k]; ++j) { const int r = (s0 == j) ? 0 : ((ns > 1u && s1 == j) ? 1 : ((ns > 2u && s2 == j) ? 2 : -1)); const bool on = (hi == 0) && (r >= 0);
            const unsigned long long m = __ballot(on); const unsigned bj = (unsigned)__builtin_amdgcn_readlane((int)mybase[k], j);
            if (on) { const unsigned pos = bj + (unsigned)__popcll(m & ((1ull << lane) - 1ull)); const unsigned val = (unsigned)(qpos | (r << 12));
                asm volatile("global_store_short %0, %1, off sc1\n\ts_nop 1" :: "v"(LIST + (size_t)j * LIST_CAP + pos), "v"(val) : "memory"); } } }
    asm volatile("s_waitcnt vmcnt(0)" ::: "memory");
    __syncthreads();
}

constexpr int ML_K = 0, ML_V = 32768;
__device__ __forceinline__ void moba_step(LAS const unsigned char* KbA, LAS const unsigned char* VbA, LAS const unsigned char* KbB, LAS const unsigned char* VbB, const bool diagA, const bool diagB, const int kv0A,
                                          const int qpos, const int q32, const int hi, const bf16x8 (&qf)[4], const f32x16& cin, f32x16& negm, f32x16& o0, f32x16& o1, float& mref, f32x16& osum, int& cin_blk) {
    const int kroff = q32 * 128, ksw = (q32 >> 1) & 7;
    const short one_ = (q32 == 0) ? (short)0x3F80 : (short)0; const bf16x8 vones = {one_, one_, one_, one_, one_, one_, one_, one_};
    constexpr bool TWO = true;
    f32x16 a0, a1, b0, b1;
#pragma unroll
    for (int tl = 0; tl < 2; ++tl) {
        LAS const unsigned char* Kb = tl ? KbB : KbA;
#pragma unroll
        for (int kh = 0; kh < 2; ++kh) {
            bf16x8 kfa[2], kfb[2];
#pragma unroll
            for (int k2 = 0; k2 < 2; ++k2) { const int ks = 2 * kh + k2; kfa[k2] = *(LAS const bf16x8*)(Kb + kroff + (((2 * ks + hi) ^ ksw) * 16)); kfb[k2] = *(LAS const bf16x8*)(Kb + 4096 + kroff + (((2 * ks + hi) ^ ksw) * 16)); }
            __builtin_amdgcn_sched_barrier(0);
#pragma unroll
            for (int k2 = 0; k2 < 2; ++k2) { const int ks = 2 * kh + k2;
                if (tl == 0) { a0 = __builtin_amdgcn_mfma_f32_32x32x16_bf16(kfa[k2], qf[ks], ks == 0 ? cin : a0, 0, 0, 0); a1 = __builtin_amdgcn_mfma_f32_32x32x16_bf16(kfb[k2], qf[ks], ks == 0 ? cin : a1, 0, 0, 0); }
                else         { b0 = __builtin_amdgcn_mfma_f32_32x32x16_bf16(kfa[k2], qf[ks], ks == 0 ? cin : b0, 0, 0, 0); b1 = __builtin_amdgcn_mfma_f32_32x32x16_bf16(kfb[k2], qf[ks], ks == 0 ? cin : b1, 0, 0, 0); } }
            __builtin_amdgcn_sched_barrier(0);
        }
    }
    if (diagA) {
        int qp2 = qpos; asm volatile("" : "+v"(qp2));
#pragma unroll
        for (int r = 0; r < 16; ++r) { const int kv = kv0A + (r & 3) + 8 * (r >> 2) + 4 * hi; if (kv > qp2) a0[r] = -INFINITY; if (kv + 32 > qp2) a1[r] = -INFINITY; }
    }
    if (diagB) {
        int qp2 = qpos; asm volatile("" : "+v"(qp2));
#pragma unroll
        for (int r = 0; r < 16; ++r) { const int kv = kv0A - 64 + (r & 3) + 8 * (r >> 2) + 4 * hi; if (kv > qp2) b0[r] = -INFINITY; if (kv + 32 > qp2) b1[r] = -INFINITY; }
    }
    float ra = __builtin_fmaxf(__builtin_fmaxf(a0[0], a0[1]), a0[2]), rb = __builtin_fmaxf(__builtin_fmaxf(a1[0], a1[1]), a1[2]);
#pragma unroll
    for (int r = 3; r < 15; r += 2) { ra = __builtin_fmaxf(__builtin_fmaxf(ra, a0[r]), a0[r + 1]); rb = __builtin_fmaxf(__builtin_fmaxf(rb, a1[r]), a1[r + 1]); }
    float rm = __builtin_fmaxf(__builtin_fmaxf(ra, rb), __builtin_fmaxf(a0[15], a1[15]));
    if (TWO) {
        float rc_ = __builtin_fmaxf(__builtin_fmaxf(b0[0], b0[1]), b0[2]), rd = __builtin_fmaxf(__builtin_fmaxf(b1[0], b1[1]), b1[2]);
#pragma unroll
        for (int r = 3; r < 15; r += 2) { rc_ = __builtin_fmaxf(__builtin_fmaxf(rc_, b0[r]), b0[r + 1]); rd = __builtin_fmaxf(__builtin_fmaxf(rd, b1[r]), b1[r + 1]); }
        rm = __builtin_fmaxf(rm, __builtin_fmaxf(__builtin_fmaxf(rc_, rd), __builtin_fmaxf(b0[15], b1[15])));
    }
    rm = xhalf_max(rm);
    if (__any(rm > 8.0f)) {
        const float d = (rm > 8.0f) ? rm : 0.f;
        mref += d;
        const float alpha = __builtin_amdgcn_exp2f(-d);
        osum[0] *= alpha;
#pragma unroll
        for (int r = 0; r < 16; ++r) { a0[r] -= d; a1[r] -= d; if (TWO) { b0[r] -= d; b1[r] -= d; } o0[r] *= alpha; o1[r] *= alpha; negm[r] = -mref; }
        cin_blk = -1;
    }
    __builtin_amdgcn_sched_barrier(0);
    bf16x8 vfa[2][2], vfc[2][2];
#pragma unroll
    for (int blk = 0; blk < 2; ++blk)
#pragma unroll
        for (int s = 0; s < 2; ++s) {
            LAS const unsigned char* vp = VbA + q32 * AL_V_STRIDE + (32 * blk + 16 * s + 4 * hi) * 2;
            const s16x4 x0 = *(LAS const s16x4*)(vp), x1 = *(LAS const s16x4*)(vp + 16);
            const s16x4 c0 = *(LAS const s16x4*)(vp + 32 * AL_V_STRIDE), c1 = *(LAS const s16x4*)(vp + 32 * AL_V_STRIDE + 16);
            vfa[blk][s] = (bf16x8){x0[0], x0[1], x0[2], x0[3], x1[0], x1[1], x1[2], x1[3]};
            vfc[blk][s] = (bf16x8){c0[0], c0[1], c0[2], c0[3], c1[0], c1[1], c1[2], c1[3]};
        }
    __builtin_amdgcn_sched_barrier(0);
#pragma unroll
    for (int r = 0; r < 16; ++r) { a0[r] = __builtin_amdgcn_exp2f(a0[r]); a1[r] = __builtin_amdgcn_exp2f(a1[r]); }
    bf16x8 pa[2][2];
#pragma unroll
    for (int s = 0; s < 2; ++s) {
        u32x4 w0 = {pk2(a0[8 * s + 0], a0[8 * s + 1]), pk2(a0[8 * s + 2], a0[8 * s + 3]), pk2(a0[8 * s + 4], a0[8 * s + 5]), pk2(a0[8 * s + 6], a0[8 * s + 7])};
        u32x4 w1 = {pk2(a1[8 * s + 0], a1[8 * s + 1]), pk2(a1[8 * s + 2], a1[8 * s + 3]), pk2(a1[8 * s + 4], a1[8 * s + 5]), pk2(a1[8 * s + 6], a1[8 * s + 7])};
        pa[0][s] = __builtin_bit_cast(bf16x8, w0); pa[1][s] = __builtin_bit_cast(bf16x8, w1);
    }
    __builtin_amdgcn_sched_barrier(0);
    if (!TWO) {
#pragma unroll
        for (int blk = 0; blk < 2; ++blk)
#pragma unroll
            for (int s = 0; s < 2; ++s) {
                o0 = __builtin_amdgcn_mfma_f32_32x32x16_bf16(vfa[blk][s], pa[blk][s], o0, 0, 0, 0);
                o1 = __builtin_amdgcn_mfma_f32_32x32x16_bf16(vfc[blk][s], pa[blk][s], o1, 0, 0, 0);
                osum = __builtin_amdgcn_mfma_f32_32x32x16_bf16(vones, pa[blk][s], osum, 0, 0, 0);
            }
    } else {
#pragma unroll
        for (int g = 0; g < 4; ++g) { const int blk = g >> 1, s = g & 1;
            o0 = __builtin_amdgcn_mfma_f32_32x32x16_bf16(vfa[blk][s], pa[blk][s], o0, 0, 0, 0);
#pragma unroll
            for (int r = 0; r < 4; ++r) b0[4 * g + r] = __builtin_amdgcn_exp2f(b0[4 * g + r]);
            __builtin_amdgcn_sched_barrier(0);
            o1 = __builtin_amdgcn_mfma_f32_32x32x16_bf16(vfc[blk][s], pa[blk][s], o1, 0, 0, 0);
#pragma unroll
            for (int r = 0; r < 4; ++r) b1[4 * g + r] = __builtin_amdgcn_exp2f(b1[4 * g + r]);
            __builtin_amdgcn_sched_barrier(0);
            osum = __builtin_amdgcn_mfma_f32_32x32x16_bf16(vones, pa[blk][s], osum, 0, 0, 0);
            __builtin_amdgcn_sched_barrier(0);
        }
        bf16x8 vga[2][2], vgc[2][2];
#pragma unroll
        for (int blk = 0; blk < 2; ++blk)
#pragma unroll
            for (int s = 0; s < 2; ++s) {
                LAS const unsigned char* vp = VbB + q32 * AL_V_STRIDE + (32 * blk + 16 * s + 4 * hi) * 2;
                const s16x4 x0 = *(LAS const s16x4*)(vp), x1 = *(LAS const s16x4*)(vp + 16);
                const s16x4 c0 = *(LAS const s16x4*)(vp + 32 * AL_V_STRIDE), c1 = *(LAS const s16x4*)(vp + 32 * AL_V_STRIDE + 16);
                vga[blk][s] = (bf16x8){x0[0], x0[1], x0[2], x0[3], x1[0], x1[1], x1[2], x1[3]};
                vgc[blk][s] = (bf16x8){c0[0], c0[1], c0[2], c0[3], c1[0], c1[1], c1[2], c1[3]};
            }
        bf16x8 pbb[2][2];
#pragma unroll
        for (int s = 0; s < 2; ++s) {
            u32x4 w0 = {pk2(b0[8 * s + 0], b0[8 * s + 1]), pk2(b0[8 * s + 2], b0[8 * s + 3]), pk2(b0[8 * s + 4], b0[8 * s + 5]), pk2(b0[8 * s + 6], b0[8 * s + 7])};
            u32x4 w1 = {pk2(b1[8 * s + 0], b1[8 * s + 1]), pk2(b1[8 * s + 2], b1[8 * s + 3]), pk2(b1[8 * s + 4], b1[8 * s + 5]), pk2(b1[8 * s + 6], b1[8 * s + 7])};
            pbb[0][s] = __builtin_bit_cast(bf16x8, w0); pbb[1][s] = __builtin_bit_cast(bf16x8, w1);
        }
        __builtin_amdgcn_sched_barrier(0);
#pragma unroll
        for (int blk = 0; blk < 2; ++blk)
#pragma unroll
            for (int s = 0; s < 2; ++s) {
                o0 = __builtin_amdgcn_mfma_f32_32x32x16_bf16(vga[blk][s], pbb[blk][s], o0, 0, 0, 0);
                o1 = __builtin_amdgcn_mfma_f32_32x32x16_bf16(vgc[blk][s], pbb[blk][s], o1, 0, 0, 0);
                osum = __builtin_amdgcn_mfma_f32_32x32x16_bf16(vones, pbb[blk][s], osum, 0, 0, 0);
            }
    }
}

__device__ __forceinline__ void moba_walk(LAS unsigned char* L, const int nt, const int q0, const int qpos, const int q32, const int hi, const int qb, const unsigned sel, const bf16x8 (&qf)[4],
                                          const bf16_t* ksrc, const bf16_t* vsrc, const int kwoff, const int vwoff, f32x16& negm, f32x16& o0, f32x16& o1, float& mref, f32x16& osum) {
    asm volatile("" : "+v"(ksrc), "+v"(vsrc));
    f32x16 cinp = negm; int cin_blk = -1;
    const int tw = (q0 + 31) >> 6;
#define ML_LOAD(tt) do { rk0 = *(const u32x4*)(ksrc + (size_t)(tt) * 4096); rv0 = *(const u32x4*)(vsrc + (size_t)(tt) * 4096); rk1 = *(const u32x4*)(ksrc + (size_t)((tt) - 1) * 4096); rv1 = *(const u32x4*)(vsrc + (size_t)((tt) - 1) * 4096); } while (0)
#define ML_STORE(tt) do { const int sa_ = (tt) & 3, sb_ = ((tt) - 1) & 3; \
        *(LAS u32x4*)(L + ML_K + sa_ * 8192 + kwoff) = rk0; *(LAS u32x2*)(L + ML_V + sa_ * AL_VB + vwoff) = (u32x2){rv0.x, rv0.y}; *(LAS u32x2*)(L + ML_V + sa_ * AL_VB + vwoff + 8) = (u32x2){rv0.z, rv0.w}; \
        *(LAS u32x4*)(L + ML_K + sb_ * 8192 + kwoff) = rk1; *(LAS u32x2*)(L + ML_V + sb_ * AL_VB + vwoff) = (u32x2){rv1.x, rv1.y}; *(LAS u32x2*)(L + ML_V + sb_ * AL_VB + vwoff + 8) = (u32x2){rv1.z, rv1.w}; } while (0)
    { u32x4 rk0, rv0, rk1, rv1; ML_LOAD(nt - 1); ML_STORE(nt - 1); }
    __syncthreads();
    for (int t = nt - 1; t > 0; t -= 2) {
        const bool more = (t >= 3);
        u32x4 rk0, rv0, rk1, rv1;
        ML_LOAD(more ? t - 2 : t);
        if (t - 1 <= tw) {
            const int nblk = t >> 2;
            if (cin_blk != nblk) { cin_blk = nblk; const bool unsel = (nblk < qb) && !((sel >> nblk) & 1u);
#pragma unroll
                for (int r = 0; r < 16; ++r) cinp[r] = unsel ? -INFINITY : negm[r]; }
            LAS const unsigned char* KA = L + ML_K + (t & 3) * 8192; LAS const unsigned char* VA = L + ML_V + (t & 3) * AL_VB;
            LAS const unsigned char* KB = L + ML_K + ((t - 1) & 3) * 8192; LAS const unsigned char* VB = L + ML_V + ((t - 1) & 3) * AL_VB;
            moba_step(KA, VA, KB, VB, t >= tw, t - 1 == tw, t * 64, qpos, q32, hi, qf, cinp, negm, o0, o1, mref, osum, cin_blk);
        }
        if (!more) break;
        ML_STORE(t - 2);
        __syncthreads();
    }
#undef ML_LOAD
#undef ML_STORE
}

__device__ __forceinline__ void moba_gather_item(const Ctx& C, const Args& a, const int l, const int c, const int len) {
    const int tid = opaque_tid(C), lane = tid & 63, wid = C.wave, q32 = lane & 31, hi = lane >> 5;
    unsigned char* ws = a.ws; unsigned char* xs = (unsigned char*)a.out;
    const int bh = l >> 4, j = l & 15;
    const bf16_t* Q = (const bf16_t*)(ws + WS_QM);
    const bf16_t* K = (const bf16_t*)(ws + WS_KM);
    const bf16_t* VT = (const bf16_t*)(ws + WS_VT) + (size_t)(64 + bh) * 64 * SEQ;
    LAS unsigned char* L = C.lds;
    { const int lrow = tid >> 3, lch = tid & 7;
      const bf16_t* ksrc = K + ((size_t)bh * SEQ + lrow) * 64 + lch * 8 + (size_t)(4 * j) * 4096;
      const bf16_t* vsrc = VT + (size_t)lrow * 64 + lch * 8 + (size_t)(4 * j) * 4096;
      const int kwoff = lrow * 128 + ((lch ^ ((lrow >> 1) & 7)) * 16), vwoff = lrow * AL_V_STRIDE + lch * 16;
      u32x4 rk[4], rv[4];
#pragma unroll
      for (int i = 0; i < 4; ++i) { rk[i] = *(const u32x4*)(ksrc + (size_t)i * 4096); rv[i] = *(const u32x4*)(vsrc + (size_t)i * 4096); }
#pragma unroll
      for (int i = 0; i < 4; ++i) { *(LAS u32x4*)(L + ML_K + i * 8192 + kwoff) = rk[i];
          *(LAS u32x2*)(L + ML_V + i * AL_VB + vwoff) = (u32x2){rv[i].x, rv[i].y}; *(LAS u32x2*)(L + ML_V + i * AL_VB + vwoff + 8) = (u32x2){rv[i].z, rv[i].w}; } }
    const int n = min(GCHUNK, len - c * GCHUNK);
    const unsigned short* LIST = (const unsigned short*)(xs + XS_LIST) + (size_t)l * LIST_CAP + c * GCHUNK;
    unsigned e1, e2;
#define LIST_LD(ix) ({ const int ix_ = (ix); const unsigned w_ = __hip_atomic_load((const unsigned*)LIST + (ix_ >> 1), __ATOMIC_RELAXED, __HIP_MEMORY_SCOPE_AGENT); (ix_ & 1) ? (w_ >> 16) : (w_ & 0xffffu); })
    { const int i0 = 32 * wid + q32, i1 = 256 + 32 * wid + q32; e1 = LIST_LD(i0 < n ? i0 : 0); e2 = LIST_LD(i1 < n ? i1 : 0); }
    bf16x8 qn[4];
    { const bf16_t* qp = Q + ((size_t)bh * SEQ + (e1 & 4095)) * 64 + hi * 8;
#pragma unroll
      for (int ks = 0; ks < 4; ++ks) qn[ks] = *(const bf16x8*)(qp + ks * 16); }
    __syncthreads();
    for (int sc = 0; sc < GCHUNK / 256; ++sc) {
        const int idx = sc * 256 + 32 * wid + q32;
        if (sc * 256 + 32 * wid >= n) break;
        const bool valid = idx < n;
        const unsigned e = e1;
        const int qpos = e & 4095, r = e >> 12;
        bf16x8 qf[4];
#pragma unroll
        for (int ks = 0; ks < 4; ++ks) qf[ks] = qn[ks];
        e1 = e2;
        { const int i2 = idx + 512; e2 = LIST_LD(i2 < n ? i2 : 0); }
        { const bf16_t* qp = Q + ((size_t)bh * SEQ + (e1 & 4095)) * 64 + hi * 8;
#pragma unroll
          for (int ks = 0; ks < 4; ++ks) qn[ks] = *(const bf16x8*)(qp + ks * 16); }
        float mref;
        { float s_ = 0.f;
#pragma unroll
          for (int ks = 0; ks < 4; ++ks) { const bf16x8 kk = *(LAS const bf16x8*)(L + ML_K + (2 * ks + hi) * 16);
#pragma unroll
              for (int jj = 0; jj < 8; ++jj) s_ += bf2f(qf[ks][jj]) * bf2f(kk[jj]); }
          mref = xhalf_sum(s_); }
        f32x16 osum = {0.f, 0.f, 0.f, 0.f, 0.f, 0.f, 0.f, 0.f, 0.f, 0.f, 0.f, 0.f, 0.f, 0.f, 0.f, 0.f}, o0 = osum, o1 = osum;
        f32x16 negm;
#pragma unroll
        for (int i = 0; i < 16; ++i) negm[i] = -mref;
        int cin_blk = 0;
        for (int p = 0; p < 2; ++p) {
            const int ta = 3 - 2 * p, tb = 2 - 2 * p;
            moba_step(L + ML_K + ta * 8192, L + ML_V + ta * AL_VB, L + ML_K + tb * 8192, L + ML_V + tb * AL_VB, false, false, 0, 0, q32, hi, qf, negm, negm, o0, o1, mref, osum, cin_blk);
        }
        const float ltot = xhalf_lo(osum[0]);
        if (valid) {
            const size_t slot = ((size_t)bh * SEQ + qpos) * 3 + r;
            bf16_t* P = (bf16_t*)(xs + XS_PART) + slot * 64 + 32 * hi;
#pragma unroll
            for (int g = 0; g < 2; ++g) {
                const u32x4 w0 = {pk2(o0[8 * g], o0[8 * g + 1]), pk2(o0[8 * g + 2], o0[8 * g + 3]), pk2(o0[8 * g + 4], o0[8 * g + 5]), pk2(o0[8 * g + 6], o0[8 * g + 7])};
                const u32x4 w1 = {pk2(o1[8 * g], o1[8 * g + 1]), pk2(o1[8 * g + 2], o1[8 * g + 3]), pk2(o1[8 * g + 4], o1[8 * g + 5]), pk2(o1[8 * g + 6], o1[8 * g + 7])};
                asm volatile("global_store_dwordx4 %0, %1, off sc1\n\ts_nop 1" :: "v"(P + 8 * g), "v"(w0) : "memory");
                asm volatile("global_store_dwordx4 %0, %1, off sc1\n\ts_nop 1" :: "v"(P + 16 + 8 * g), "v"(w1) : "memory");
            }
            if (hi == 0) { const f32x2 mlv = {mref, ltot}; asm volatile("global_store_dwordx2 %0, %1, off sc1\n\ts_nop 1" :: "v"((float*)(xs + XS_ML) + slot * 2), "v"(mlv) : "memory"); }
        }
    }
    asm volatile("s_waitcnt vmcnt(0)" ::: "memory");
    __syncthreads();
    if (tid == 0) __hip_atomic_fetch_add((unsigned*)(ws + WS_CTL) + CW_GDONE + 32 * bh, 1u, __ATOMIC_RELAXED, __HIP_MEMORY_SCOPE_AGENT);
}

__device__ __forceinline__ void moba_own_item(const Ctx& C, const Args& a, const int bh, const int qb) {
    const int tid = opaque_tid(C), lane = tid & 63, wid = C.wave, q32 = lane & 31, hi = lane >> 5;
    unsigned char* ws = a.ws; const unsigned char* xs = (const unsigned char*)a.out;
    const int b = bh >> 3, h = bh & 7;
    const bf16_t* Q = (const bf16_t*)(ws + WS_QM);
    const bf16_t* K = (const bf16_t*)(ws + WS_KM);
    const bf16_t* VT = (const bf16_t*)(ws + WS_VT) + (size_t)(64 + bh) * 64 * SEQ;
    LAS unsigned char* L = C.lds;
    const int qrel = 32 * wid + q32, qpos = qb * 256 + qrel;
    { const int lrow = tid >> 3, lch = tid & 7;
      const bf16_t* ksrc = K + ((size_t)bh * SEQ + lrow) * 64 + lch * 8 + (size_t)(4 * qb) * 4096;
      const bf16_t* vsrc = VT + (size_t)lrow * 64 + lch * 8 + (size_t)(4 * qb) * 4096;
      const int kwoff = lrow * 128 + ((lch ^ ((lrow >> 1) & 7)) * 16), vwoff = lrow * AL_V_STRIDE + lch * 16;
      u32x4 rk[4], rv[4];
#pragma unroll
      for (int i = 0; i < 4; ++i) { rk[i] = *(const u32x4*)(ksrc + (size_t)i * 4096); rv[i] = *(const u32x4*)(vsrc + (size_t)i * 4096); }
#pragma unroll
      for (int i = 0; i < 4; ++i) { *(LAS u32x4*)(L + ML_K + i * 8192 + kwoff) = rk[i];
          *(LAS u32x2*)(L + ML_V + i * AL_VB + vwoff) = (u32x2){rv[i].x, rv[i].y}; *(LAS u32x2*)(L + ML_V + i * AL_VB + vwoff + 8) = (u32x2){rv[i].z, rv[i].w}; } }
    bf16x8 qf[4];
    { const bf16_t* qp = Q + ((size_t)bh * SEQ + qpos) * 64 + hi * 8;
#pragma unroll
      for (int ks = 0; ks < 4; ++ks) qf[ks] = *(const bf16x8*)(qp + ks * 16); }
    const int ns = qb < 3 ? qb : 3; const size_t slot0 = ((size_t)bh * SEQ + qpos) * 3;
    f32x2 ml[3];
#pragma unroll
    for (int r = 0; r < 3; ++r) { ml[r] = (f32x2){0.f, 0.f};
        if (r < ns) { const unsigned long long v_ = __hip_atomic_load((const unsigned long long*)((const float*)(xs + XS_ML) + (slot0 + r) * 2), __ATOMIC_RELAXED, __HIP_MEMORY_SCOPE_AGENT);
            ml[r] = (f32x2){__uint_as_float((unsigned)v_), __uint_as_float((unsigned)(v_ >> 32))}; } }
    __syncthreads();
    float mref;
    { const int kr = qrel & 63; LAS const unsigned char* Kr = L + ML_K + (qrel >> 6) * 8192 + kr * 128; const int ksw_ = (kr >> 1) & 7; float s_ = 0.f;
#pragma unroll
      for (int ks = 0; ks < 4; ++ks) { const bf16x8 kk = *(LAS const bf16x8*)(Kr + (((2 * ks + hi) ^ ksw_) * 16));
#pragma unroll
          for (int jj = 0; jj < 8; ++jj) s_ += bf2f(qf[ks][jj]) * bf2f(kk[jj]); }
      mref = xhalf_sum(s_); }
    f32x16 osum = {0.f, 0.f, 0.f, 0.f, 0.f, 0.f, 0.f, 0.f, 0.f, 0.f, 0.f, 0.f, 0.f, 0.f, 0.f, 0.f}, o0 = osum, o1 = osum;
    f32x16 negm;
#pragma unroll
    for (int i = 0; i < 16; ++i) negm[i] = -mref;
    const int tw = (32 * wid + 31) >> 6;
    int cin_blk = 0;
    for (int p = (tw >= 2 ? 0 : 1); p < 2; ++p) {
        const int ta = 3 - 2 * p, tb = 2 - 2 * p;
        moba_step(L + ML_K + ta * 8192, L + ML_V + ta * AL_VB, L + ML_K + tb * 8192, L + ML_V + tb * AL_VB, ta >= tw, tb == tw, ta * 64, qrel, q32, hi, qf, negm, negm, o0, o1, mref, osum, cin_blk);
    }
    float ltot = xhalf_lo(osum[0]);
    if (qb > 0) {
        u32x4 pv[3][4];
#pragma unroll
        for (int r = 0; r < 3; ++r) if (r < ns) { const bf16_t* P = (const bf16_t*)(xs + XS_PART) + (slot0 + r) * 64 + 32 * hi;
#pragma unroll
            for (int g = 0; g < 2; ++g) { pv[r][g] = *(const u32x4*)(P + 8 * g); pv[r][2 + g] = *(const u32x4*)(P + 16 + 8 * g); } }
        float M = mref;
#pragma unroll
        for (int r = 0; r < 3; ++r) if (r < ns) M = __builtin_fmaxf(M, ml[r].x);
        const float so = __builtin_amdgcn_exp2f(mref - M);
        ltot *= so;
#pragma unroll
        for (int i = 0; i < 16; ++i) { o0[i] *= so; o1[i] *= so; }
#pragma unroll
        for (int r = 0; r < 3; ++r) if (r < ns) { const float sr = __builtin_amdgcn_exp2f(ml[r].x - M); ltot += sr * ml[r].y;
#pragma unroll
            for (int g = 0; g < 2; ++g) { const u32x4 u0 = pv[r][g], u1 = pv[r][2 + g];
                o0[8 * g] += sr * bflo(u0.x); o0[8 * g + 1] += sr * bfhi(u0.x); o0[8 * g + 2] += sr * bflo(u0.y); o0[8 * g + 3] += sr * bfhi(u0.y);
                o0[8 * g + 4] += sr * bflo(u0.z); o0[8 * g + 5] += sr * bfhi(u0.z); o0[8 * g + 6] += sr * bflo(u0.w); o0[8 * g + 7] += sr * bfhi(u0.w);
                o1[8 * g] += sr * bflo(u1.x); o1[8 * g + 1] += sr * bfhi(u1.x); o1[8 * g + 2] += sr * bflo(u1.y); o1[8 * g + 3] += sr * bfhi(u1.y);
                o1[8 * g + 4] += sr * bflo(u1.z); o1[8 * g + 5] += sr * bfhi(u1.z); o1[8 * g + 6] += sr * bflo(u1.w); o1[8 * g + 7] += sr * bfhi(u1.w); } }
    }
    const float rl = 1.0f / ltot;
    bf16_t* Y = (bf16_t*)(ws + WS_HB) + (size_t)T * AW + ((size_t)b * SEQ + qpos) * AW + h * 64 + 4 * hi;
#pragma unroll
    for (int g = 0; g < 4; ++g) {
        *(u32x2*)(Y + 8 * g) = (u32x2){pk2(o0[4 * g] * rl, o0[4 * g + 1] * rl), pk2(o0[4 * g + 2] * rl, o0[4 * g + 3] * rl)};
        *(u32x2*)(Y + 32 + 8 * g) = (u32x2){pk2(o1[4 * g] * rl, o1[4 * g + 1] * rl), pk2(o1[4 * g + 2] * rl, o1[4 * g + 3] * rl)};
    }
    __syncthreads();
}

__device__ __forceinline__ void attn_unit(const Ctx& C, const Args& a, int type, int bh, int qb) {
    const int tid_ = opaque_tid(C), lane_ = tid_ & 63;
    unsigned char* ws = a.ws;
    const int tid = tid_, lane = lane_, wid = C.wave, q32 = lane & 31, hi = lane >> 5;
    const int b = bh >> 3, h = bh & 7;
    const bf16_t* Q = (const bf16_t*)(ws + (type ? WS_QM : WS_QF));
    const bf16_t* K = (const bf16_t*)(ws + (type ? WS_KM : WS_KF));
    const bf16_t* VT = (const bf16_t*)(ws + WS_VT) + (size_t)(type * 64 + bh) * 64 * SEQ;
    const float* C2 = (const float*)(ws + WS_C2) + (size_t)bh * SEQ;
    const size_t rowbase = (size_t)b * SEQ;
    const int q0 = qb * 256 + wid * 32, qpos = q0 + q32;
    bf16x8 qf[4];
    { const bf16_t* qp = Q + ((size_t)bh * SEQ + qpos) * 64 + hi * 8;
#pragma unroll
      for (int ks = 0; ks < 4; ++ks) qf[ks] = *(const bf16x8*)(qp + ks * 16); }
    const unsigned sel = 0u;
    const float cq = (type == 0) ? C2[qpos] : 0.f;
    const int nt = (type == 0) ? 4 * (qb + 1) : 4;
    float qkb = 0.f;
    if (type == 0) {
        float qs = 0.f;
#pragma unroll
        for (int ks = 0; ks < 4; ++ks)
#pragma unroll
            for (int j = 0; j < 8; ++j) { const float v = bf2f(qf[ks][j]); qs += v * v; }
        qs = xhalf_sum(qs);
        const unsigned* KMX = (const unsigned*)(ws + WS_CTL) + CW_KMAX + 64 * (bh * 2);
        const float kmx = __uint_as_float(__hip_atomic_load(KMX, __ATOMIC_RELAXED, __HIP_MEMORY_SCOPE_AGENT)) + __uint_as_float(__hip_atomic_load(KMX + 64, __ATOMIC_RELAXED, __HIP_MEMORY_SCOPE_AGENT));
        qkb = sqrtf(qs * kmx) * 1.02f + cq;
    }
    const int lrow = tid >> 3, lch = tid & 7;
    const bf16_t* ksrc = K + ((size_t)bh * SEQ + lrow) * 64 + lch * 8;
    const bf16_t* vsrc = VT + (size_t)lrow * 64 + lch * 8;
    const int kwoff = lrow * 128 + ((lch ^ ((lrow >> 1) & 7)) * 16);
    const int vwoff = lrow * AL_V_STRIDE + lch * 16;
    LAS unsigned char* L = C.lds;
    float mref;
    { const bf16_t* kp = K + ((size_t)bh * SEQ + qpos) * 64 + hi * 8; float s_ = 0.f;
#pragma unroll
      for (int ks = 0; ks < 4; ++ks) { const bf16x8 kk = *(const bf16x8*)(kp + ks * 16);
#pragma unroll
          for (int j = 0; j < 8; ++j) s_ += bf2f(qf[ks][j]) * bf2f(kk[j]); }
      mref = xhalf_sum(s_); }
    f32x16 osum = {0.f, 0.f, 0.f, 0.f, 0.f, 0.f, 0.f, 0.f, 0.f, 0.f, 0.f, 0.f, 0.f, 0.f, 0.f, 0.f};
    const float base = cq;
    f32x16 negm;
#pragma unroll
    for (int r = 0; r < 16; ++r) negm[r] = base - mref;
    f32x16 o0 = {0.f, 0.f, 0.f, 0.f, 0.f, 0.f, 0.f, 0.f, 0.f, 0.f, 0.f, 0.f, 0.f, 0.f, 0.f, 0.f}, o1 = o0;
    if (type == 0) {
        volatile LAS unsigned* VOTE = (volatile LAS unsigned*)(L + AL_VOTE);
        u32x4 rk, rv; float rc = 0.f;
        { const int kvs = (nt - 1) * 64;
          rk = *(const u32x4*)(ksrc + (size_t)(nt - 1) * 4096); rv = *(const u32x4*)(vsrc + (size_t)(nt - 1) * 4096); if (tid < 64) rc = C2[kvs + tid]; }
        { const int bsel = (nt - 1) & 1, vsel = (nt - 1) % 3;
          *(LAS u32x4*)(L + AL_K + bsel * 8192 + kwoff) = rk; *(LAS u32x2*)(L + AL_V + vsel * AL_VB + vwoff) = (u32x2){rv.x, rv.y}; *(LAS u32x2*)(L + AL_V + vsel * AL_VB + vwoff + 8) = (u32x2){rv.z, rv.w};
          if (tid < 64) *(LAS float*)(L + AL_C + bsel * 256 + tid * 4) = rc; }
        __syncthreads();
        attn_loop<false, 0>(L, VOTE, nt, tid, lane, wid, q0, qpos, q32, hi, qb, sel, base, qkb, qf, ksrc, vsrc, C2, kwoff, vwoff, rk, rv, rc, negm, o0, o1, mref, osum);
    } else moba_walk(L, 4, wid * 32, wid * 32 + q32, q32, hi, 0, 0u, qf, ksrc + (size_t)(4 * qb) * 4096, vsrc + (size_t)(4 * qb) * 4096, kwoff, vwoff, negm, o0, o1, mref, osum);
    __syncthreads();
    float ltot = xhalf_lo(osum[0]);
    if (type == 1 && qb > 0) {
        const unsigned char* xs = (const unsigned char*)a.out;
        const int ns = qb < 3 ? qb : 3; const size_t slot0 = ((size_t)bh * SEQ + qpos) * 3;
        f32x2 ml[3]; u32x4 pv[3][4];
#pragma unroll
        for (int r = 0; r < 3; ++r) if (r < ns) { ml[r] = *(const f32x2*)((const float*)(xs + XS_ML) + (slot0 + r) * 2);
            const bf16_t* P = (const bf16_t*)(xs + XS_PART) + (slot0 + r) * 64 + 32 * hi;
#pragma unroll
            for (int g = 0; g < 2; ++g) { pv[r][g] = *(const u32x4*)(P + 8 * g); pv[r][2 + g] = *(const u32x4*)(P + 16 + 8 * g); } }
        float M = mref;
#pragma unroll
        for (int r = 0; r < 3; ++r) if (r < ns) M = __builtin_fmaxf(M, ml[r].x);
        const float so = __builtin_amdgcn_exp2f(mref - M);
        ltot *= so;
#pragma unroll
        for (int i = 0; i < 16; ++i) { o0[i] *= so; o1[i] *= so; }
#pragma unroll
        for (int r = 0; r < 3; ++r) if (r < ns) { const float sr = __builtin_amdgcn_exp2f(ml[r].x - M); ltot += sr * ml[r].y;
#pragma unroll
            for (int g = 0; g < 2; ++g) { const u32x4 u0 = pv[r][g], u1 = pv[r][2 + g];
                o0[8 * g] += sr * bflo(u0.x); o0[8 * g + 1] += sr * bfhi(u0.x); o0[8 * g + 2] += sr * bflo(u0.y); o0[8 * g + 3] += sr * bfhi(u0.y);
                o0[8 * g + 4] += sr * bflo(u0.z); o0[8 * g + 5] += sr * bfhi(u0.z); o0[8 * g + 6] += sr * bflo(u0.w); o0[8 * g + 7] += sr * bfhi(u0.w);
                o1[8 * g] += sr * bflo(u1.x); o1[8 * g + 1] += sr * bfhi(u1.x); o1[8 * g + 2] += sr * bflo(u1.y); o1[8 * g + 3] += sr * bfhi(u1.y);
                o1[8 * g + 4] += sr * bflo(u1.z); o1[8 * g + 5] += sr * bfhi(u1.z); o1[8 * g + 6] += sr * bflo(u1.w); o1[8 * g + 7] += sr * bfhi(u1.w); } }
    }
    const float rl = 1.0f / ltot;
    bf16_t* Y = (bf16_t*)(ws + WS_HB) + (size_t)type * T * AW + (rowbase + qpos) * AW + h * 64 + 4 * hi;
#pragma unroll
    for (int g = 0; g < 4; ++g) {
        *(u32x2*)(Y + 8 * g) = (u32x2){pk2(o0[4 * g] * rl, o0[4 * g + 1] * rl), pk2(o0[4 * g + 2] * rl, o0[4 * g + 3] * rl)};
        *(u32x2*)(Y + 32 + 8 * g) = (u32x2){pk2(o1[4 * g] * rl, o1[4 * g + 1] * rl), pk2(o1[4 * g + 2] * rl, o1[4 * g + 3] * rl)};
    }
}


struct P4Sched {
    const char* A; const char* B; int vcu, G;
    __device__ __forceinline__ bool next(int i, pg8::GUnit& u) const {
        const int L = i * G + vcu; if (L >= 512) return false;
        const int pm = L >> 2, pn = L & 3; u.x0 = pm; u.x1 = pn; u.x2 = 0; u.x3 = 0;
        u.a0 = A + (size_t)pm * 256 * 2048; u.a1 = u.a0 + (size_t)128 * 2048; u.b0 = B + (size_t)pn * 256 * 2048; u.b1 = u.b0 + (size_t)128 * 2048; return true; }
};
struct P4Epi {
    const float* x; bf16_t* xb;
    __device__ __forceinline__ void operator()(Acc& acc, const pg8::GUnit& u, int wr, int wc, int fr, int fq) const {
        const int cb = u.x1 * 256 + 32 * wc + 8 * fq;
#pragma unroll
        for (int ai = 0; ai < 2; ++ai)
#pragma unroll
            for (int mh = 0; mh < 2; ++mh) {
                f32x4 xv[2][2][2];
#pragma unroll
                for (int m2 = 0; m2 < 2; ++m2) { const size_t ro = (size_t)(u.x0 * 256 + 128 * ai + 64 * wr + RL(2 * mh + m2, fr)) * DM + cb;
#pragma unroll
                    for (int bj = 0; bj < 2; ++bj)
#pragma unroll
                        for (int n = 0; n < 2; ++n) xv[m2][bj][n] = *(const f32x4*)(x + ro + 128 * bj + 4 * n); }
#pragma unroll
                for (int m2 = 0; m2 < 2; ++m2) { const int m = 2 * mh + m2; const size_t ro = (size_t)(u.x0 * 256 + 128 * ai + 64 * wr + RL(m, fr)) * DM + cb;
#pragma unroll
                    for (int bj = 0; bj < 2; ++bj)
#pragma unroll
                        for (int n = 0; n < 2; ++n) { const f32x4 v = xv[m2][bj][n] + acc[ai][bj][m][n]; *(u32x2*)(xb + ro + 128 * bj + 4 * n) = (u32x2){pk2(v.x, v.y), pk2(v.z, v.w)}; } }
                EPI_FENCE(); }
    }
};

template <bool FINAL>
__device__ __forceinline__ void p5_wave(const Ctx& C, const Args& a, int task) {
    const int tid_ = opaque_tid(C), lane = tid_ & 63, fr = lane & 15, fq = lane >> 4;
    unsigned char* ws = a.ws;
    const int tok0 = task * 16;
    const bf16_t* xr = (const bf16_t*)(ws + WS_X1) + (size_t)(tok0 + fr) * DM + 8 * fq;
    const u32x4* WH = (const u32x4*)(ws + WS_WRH) + lane; const u32x4* WL = (const u32x4*)(ws + WS_WRL) + lane;
    f32x4 acc[3] = {{0.f, 0.f, 0.f, 0.f}, {0.f, 0.f, 0.f, 0.f}, {0.f, 0.f, 0.f, 0.f}};
    float ss = 0.f;
#pragma unroll 4
    for (int ks = 0; ks < 32; ++ks) {
        const u32x4 hw = *(const u32x4*)(xr + 32 * ks);
        { const float a0 = bflo(hw.x), a1 = bfhi(hw.x), a2 = bflo(hw.y), a3 = bfhi(hw.y), a4 = bflo(hw.z), a5 = bfhi(hw.z), a6 = bflo(hw.w), a7 = bfhi(hw.w);
          ss += (a0 * a0 + a1 * a1) + (a2 * a2 + a3 * a3) + (a4 * a4 + a5 * a5) + (a6 * a6 + a7 * a7); }
        const bf16x8 ah = __builtin_bit_cast(bf16x8, hw);
#pragma unroll
        for (int nf = 0; nf < 3; ++nf) {
            const bf16x8 bh = __builtin_bit_cast(bf16x8, WH[(ks * 3 + nf) * 64]), bl = __builtin_bit_cast(bf16x8, WL[(ks * 3 + nf) * 64]);
            acc[nf] = __builtin_amdgcn_mfma_f32_16x16x32_bf16(bh, ah, acc[nf], 0, 0, 0);
            acc[nf] = __builtin_amdgcn_mfma_f32_16x16x32_bf16(bl, ah, acc[nf], 0, 0, 0);
        }
    }
    ss += __shfl_xor(ss, 16); ss += __shfl_xor(ss, 32);
    const float rstd = 1.0f / sqrtf(ss * (1.0f / DM) + RMS_EPS);
    LAS float* sc = (LAS float*)(C.lds + C.wave * 3072);
#pragma unroll
    for (int nf = 0; nf < 3; ++nf) *(LAS f32x4*)(sc + fr * 48 + 16 * nf + 4 * fq) = acc[nf] * rstd;
    asm volatile("s_waitcnt lgkmcnt(0)" ::: "memory");
    int ea = -1, eb = -1; const int tok = tok0 + lane;
    if (lane < 16) {
        float lg[36];
#pragma unroll
        for (int c4 = 0; c4 < 9; ++c4) { const f32x4 v = *(LAS const f32x4*)(sc + lane * 48 + 4 * c4); lg[4 * c4] = v.x; lg[4 * c4 + 1] = v.y; lg[4 * c4 + 2] = v.z; lg[4 * c4 + 3] = v.w; }
        ((float*)(ws + WS_RSTD2))[tok] = rstd;
        float g4[4];
#pragma unroll
        for (int c = 0; c < 4; ++c) g4[c] = lg[c] + a.in[10][c];
        int gi = 0; float gm = g4[0];
#pragma unroll
        for (int c = 1; c < 4; ++c) if (g4[c] > gm) { gm = g4[c]; gi = c; }
        float gs = 0.f;
#pragma unroll
        for (int c = 0; c < 4; ++c) gs += __expf(g4[c] - gm);
        const float gtop = 1.0f / gs;
        float lf[8];
#pragma unroll
        for (int j = 0; j < 8; ++j) { const float v0 = lg[4 + j], v1 = lg[12 + j], v2 = lg[20 + j], v3 = lg[28 + j];
            const float v = (gi == 0) ? v0 : (gi == 1) ? v1 : (gi == 2) ? v2 : v3; lf[j] = v + a.in[12][gi * 8 + j]; }
        int i1 = 0, i2 = 0; float f1 = -INFINITY, f2 = -INFINITY;
#pragma unroll
        for (int j = 0; j < 8; ++j) { if (lf[j] > f1) { f2 = f1; i2 = i1; f1 = lf[j]; i1 = j; } else if (lf[j] > f2) { f2 = lf[j]; i2 = j; } }
        const float e2 = __expf(f2 - f1), den = 1.0f / (1.0f + e2);
        float* TW = (float*)(ws + WS_TOKW);
        TW[tok * 2] = gtop * den; TW[tok * 2 + 1] = gtop * e2 * den;
        ea = gi * 8 + i1; eb = gi * 8 + i2;
    }
    if (FINAL) {
        unsigned* CNT = (unsigned*)(ws + WS_CTL) + CW_CNT; int* LISTS = (int*)(ws + WS_LISTS);
        unsigned mym1 = 0u, mym2 = 0u;
        for (int e = 0; e < NE; ++e) { const unsigned m1 = (unsigned)__ballot(ea == e), m2 = (unsigned)__ballot(eb == e); if (lane == e) { mym1 = m1; mym2 = m2; } }
        const int n1 = __popc(mym1), n2 = __popc(mym2);
        unsigned base = 0u;
        if (lane < NE && n1 + n2 > 0) base = __hip_atomic_fetch_add(CNT + 64 * lane, (unsigned)(n1 + n2), __ATOMIC_RELAXED, __HIP_MEMORY_SCOPE_AGENT);
        const int sa = (ea < 0) ? 0 : ea, sb = (eb < 0) ? 0 : eb;
        const unsigned ba = __shfl(base, sa), ma1 = __shfl(mym1, sa);
        const unsigned bb = __shfl(base, sb), mb1 = __shfl(mym1, sb), mb2 = __shfl(mym2, sb);
        const unsigned ltm = (1u << (lane & 31)) - 1u;
        if (ea >= 0) {
            LISTS[(size_t)ea * T + ba + __popc(ma1 & ltm)] = tok * 2;
            LISTS[(size_t)eb * T + bb + __popc(mb1) + __popc(mb2 & ltm)] = tok * 2 + 1;
        }
    }
}

__device__ __forceinline__ int moe_tiles(const Ctx& C, const Args& a, LAS int* tst) {
    const int tid_ = opaque_tid(C);
    if (tid_ < 64) {
        const unsigned* CNT = (const unsigned*)(a.ws + WS_CTL) + CW_CNT;
        const int c = (tid_ < NE) ? (int)__hip_atomic_load(CNT + 64 * tid_, __ATOMIC_RELAXED, __HIP_MEMORY_SCOPE_AGENT) : 0;
        const int nt_ = (c + 255) >> 8; int inc = nt_;
#pragma unroll
        for (int o = 1; o < 32; o <<= 1) { const int nb = __shfl_up(inc, o); if (tid_ >= o) inc += nb; }
        if (tid_ < NE) { tst[tid_] = inc - nt_; tst[33 + tid_] = c; }
        if (tid_ == NE - 1) tst[32] = inc;
    }
    __syncthreads();
    return tst[32];
}


constexpr int UD_OFF = MISC_OFF + 1024, UL_OFF = MISC_OFF + 2048, DTE_OFF = MISC_OFF + 10240, DTW_OFF = MISC_OFF + 18432;
__device__ __forceinline__ int moe_down_unit(int nun, int v, int G, int i, int& n7) {
    const int U = nun / G, r = nun - U * G, cap = (3 * nun + G - 1) / G;
    const int capv = cap - 2 * (U + (v < r ? 1 : 0)), s0 = v * (cap - 1) - 2 * (v * U + min(v, r));
    const int c = max(0, min(min(capv - 1, 7), (nun - G) - s0));
    n7 = (v < nun) ? 1 + c : 0;
    return i == 0 ? v : nun - s0 - c + (i - 1);
}
__device__ __forceinline__ int moe_prepare(const Ctx& C, const Args& a, LAS int* tst) {
    const int tid_ = opaque_tid(C);
    const int ntile = moe_tiles(C, a, tst);
    LAS int* UD = (LAS int*)(C.lds + UD_OFF); LAS int* UL = (LAS int*)(C.lds + UL_OFF);
    const int nun = ntile * 4;
    if (tid_ < 16) {
        const int i = tid_ & 7, dn = tid_ >> 3;
        int n7; const int du = moe_down_unit(nun, C.vcu, C.G, i, n7);
        const int u = dn ? (i < n7 ? du : nun) : i * C.G + C.vcu;
        if (u < nun) {
            const int gt = u >> 2; int e = 0;
            for (int j = 1; j < NE; ++j) if (tst[j] <= gt) e = j;
            const int rt = gt - tst[e], nvalid = tst[33 + e] - rt * 256;
            LAS int* d = UD + dn * 64 + i * 8;
            d[0] = e; d[1] = gt; d[2] = u & 3; d[3] = nvalid; d[4] = rt;
        }
    }
    __syncthreads();
    {
        const int i = tid_ >> 6, l = tid_ & 63;
        if (i * C.G + C.vcu < nun) {
            const int e = UD[i * 8 + 0], nvalid = UD[i * 8 + 3], rt = UD[i * 8 + 4];
            const int* LIST = (const int*)(a.ws + WS_LISTS) + (size_t)e * T + rt * 256;
            int v[4];
#pragma unroll
            for (int k = 0; k < 4; ++k) v[k] = (l + 64 * k < nvalid) ? LIST[l + 64 * k] : -1;
#pragma unroll
            for (int k = 0; k < 4; ++k) UL[i * 256 + l + 64 * k] = v[k];
        }
    }
    {
        const int i = tid_ >> 6, l = tid_ & 63; int n7; (void)moe_down_unit(nun, C.vcu, C.G, 0, n7);
        if (i < n7) {
            const int e = UD[64 + i * 8 + 0], nvalid = UD[64 + i * 8 + 3], rt = UD[64 + i * 8 + 4];
            const int* LIST = (const int*)(a.ws + WS_LISTS) + (size_t)e * T + rt * 256; const float* TW = (const float*)(a.ws + WS_TOKW);
            int v[4]; float w[4];
#pragma unroll
            for (int k = 0; k < 4; ++k) v[k] = (l + 64 * k < nvalid) ? LIST[l + 64 * k] : -1;
#pragma unroll
            for (int k = 0; k < 4; ++k) w[k] = (v[k] >= 0) ? TW[v[k]] : 0.f;
            LAS int* DTE = (LAS int*)(C.lds + DTE_OFF); LAS float* DTW = (LAS float*)(C.lds + DTW_OFF);
#pragma unroll
            for (int k = 0; k < 4; ++k) { DTE[i * 256 + l + 64 * k] = v[k]; DTW[i * 256 + l + 64 * k] = w[k]; }
        }
    }
    __syncthreads();
    return nun;
}


struct MoeSched {
    const char* XB; const char* WG; const char* WU; const char* HB_; const char* WD; LAS const int* UD; LAS const int* UL; unsigned* ctl; int n6, n7;
    __device__ __forceinline__ bool next(int i, pg8::SUnit& u) const {
        if (i < 2 * n6) { const int it = i >> 1, half = i & 1;
            const int e = __builtin_amdgcn_readfirstlane(UD[it * 8 + 0]), gt = __builtin_amdgcn_readfirstlane(UD[it * 8 + 1]), pn4 = __builtin_amdgcn_readfirstlane(UD[it * 8 + 2]);
            u.x0 = it; u.x1 = pn4; u.x2 = gt; u.x3 = 0; u.a0 = XB + half * 1024; u.a1 = u.a0;
            u.b0 = WG + ((size_t)e * DE + pn4 * 128) * 2048 + half * 1024; u.b1 = WU + ((size_t)e * DE + pn4 * 128) * 2048 + half * 1024;
            u.flags = pg8::SF_PITCH1 | pg8::SF_GATHER | (half == 0 ? pg8::SF_CHAIN : pg8::SF_PUBLISH); return true; }
        if (i < 2 * n6 + n7) { const int it = i - 2 * n6;
            const int e = __builtin_amdgcn_readfirstlane(UD[64 + it * 8 + 0]), gt = __builtin_amdgcn_readfirstlane(UD[64 + it * 8 + 1]), pn = __builtin_amdgcn_readfirstlane(UD[64 + it * 8 + 2]);
            u.x0 = it; u.x1 = pn; u.x2 = gt; u.x3 = 1; u.a0 = HB_ + (size_t)gt * 256 * 1024; u.a1 = u.a0 + (size_t)128 * 1024;
            u.b0 = WD + ((size_t)e * DM + pn * 256) * 1024; u.b1 = u.b0 + (size_t)128 * 1024; u.flags = pg8::SF_WAIT; return true; }
        return false; }
    __device__ __forceinline__ void avoff(const pg8::SUnit& u, const int (&RR)[2], const int (&CC)[2], unsigned (&v0)[2], unsigned (&v1)[2]) const {
#pragma unroll
        for (int i = 0; i < 2; ++i) { const int e0 = UL[u.x0 * 256 + RR[i]], e1 = UL[u.x0 * 256 + 128 + RR[i]];
            v0[i] = (unsigned)((e0 < 0 ? 0 : (e0 >> 1)) * 2048 + CC[i] * 2); v1[i] = (unsigned)((e1 < 0 ? 0 : (e1 >> 1)) * 2048 + CC[i] * 2); } }
    __device__ __forceinline__ void a_ready(const pg8::SUnit& u, int wid) const {
        if (u.flags & pg8::SF_WAIT) {
            if (wid == 0) { unsigned* cnt = ctl + CW_MOE + 64 * u.x2; unsigned sp = 0u;
                while ((unsigned)__builtin_amdgcn_readfirstlane(__hip_atomic_load(cnt, __ATOMIC_RELAXED, __HIP_MEMORY_SCOPE_AGENT)) < 32u) {
                    __builtin_amdgcn_s_sleep(2);
                    if (++sp > (1u << 22)) { if (lane_id_() == 0) __hip_atomic_store(ctl + CW_XTMO, 2u, __ATOMIC_RELAXED, __HIP_MEMORY_SCOPE_AGENT); break; } }
                asm volatile("s_waitcnt vmcnt(0)" ::: "memory"); }
            asm volatile("" ::: "memory"); __builtin_amdgcn_s_barrier(); asm volatile("" ::: "memory");
        } }
    __device__ __forceinline__ void done(const pg8::SUnit& u, int lane) const {
        if (u.flags & pg8::SF_PUBLISH) { asm volatile("s_waitcnt vmcnt(0)" ::: "memory");
            if (lane == 0) __hip_atomic_fetch_add(ctl + CW_MOE + 64 * u.x2, 1u, __ATOMIC_RELAXED, __HIP_MEMORY_SCOPE_AGENT); } }
};
struct MoeEpi {
    const float* RS; bf16_t* HBUF; const float* TW; bf16_t* CT; LAS const int* UL; LAS const int* UD; const int* LISTS;
    __device__ __forceinline__ void operator()(Acc& acc, const pg8::SUnit& u, int wr, int wc, int fr, int fq) const {
        if (u.x3 == 0) {
            const int cb = u.x1 * 128 + 32 * wc + 8 * fq;
            float rsv[2][4];
#pragma unroll
            for (int ai = 0; ai < 2; ++ai)
#pragma unroll
                for (int m = 0; m < 4; ++m) { const int ent = UL[u.x0 * 256 + 128 * ai + 64 * wr + RL(m, fr)]; rsv[ai][m] = (ent >= 0) ? RS[ent >> 1] : 0.f; }
#pragma unroll
            for (int ai = 0; ai < 2; ++ai)
#pragma unroll
                for (int m = 0; m < 4; ++m) { const int r = 128 * ai + 64 * wr + RL(m, fr); const float rs = rsv[ai][m];
                    bf16_t* rp = HBUF + (size_t)(u.x2 * 256 + r) * DE + cb;
                    u32x4 hw;
#pragma unroll
                    for (int n = 0; n < 2; ++n) { const f32x4 g = acc[ai][0][m][n] * rs, up = acc[ai][1][m][n] * rs;
                        const float h0 = g.x * sigmoidf_(g.x) * up.x, h1 = g.y * sigmoidf_(g.y) * up.y, h2 = g.z * sigmoidf_(g.z) * up.z, h3 = g.w * sigmoidf_(g.w) * up.w;
                        hw[2 * n] = pk2(h0, h1); hw[2 * n + 1] = pk2(h2, h3); }
                    asm volatile("global_store_dwordx4 %0, %1, off sc1\n\ts_nop 1" :: "v"(rp), "v"(hw) : "memory");
                    EPI_FENCE(); }
        } else {
            const int cb = u.x1 * 256 + 32 * wc + 8 * fq;
            LAS const int* DTE = (LAS const int*)((LAS const unsigned char*)UD - UD_OFF + DTE_OFF) + u.x0 * 256; LAS const float* DTW = (LAS const float*)((LAS const unsigned char*)UD - UD_OFF + DTW_OFF) + u.x0 * 256;
            int entv[2][4]; float wv[2][4];
#pragma unroll
            for (int ai = 0; ai < 2; ++ai)
#pragma unroll
                for (int m = 0; m < 4; ++m) { const int r = 128 * ai + 64 * wr + RL(m, fr); entv[ai][m] = DTE[r]; wv[ai][m] = DTW[r]; }
#pragma unroll
            for (int ai = 0; ai < 2; ++ai)
#pragma unroll
                for (int m = 0; m < 4; ++m) { const int ent = entv[ai][m];
                    if (ent >= 0) { const float wgt = wv[ai][m]; bf16_t* rp = CT + (size_t)ent * DM + cb;
#pragma unroll
                        for (int bj = 0; bj < 2; ++bj)
#pragma unroll
                            for (int n = 0; n < 2; ++n) { const f32x4 v = acc[ai][bj][m][n] * wgt; *(u32x2*)(rp + 128 * bj + 4 * n) = (u32x2){pk2(v.x, v.y), pk2(v.z, v.w)}; } }
                    EPI_FENCE(); }
        }
    }
};

__device__ __forceinline__ void phase8(const Ctx& C, const Args& a, float* dst) {
    const int tid_ = opaque_tid(C), lane_ = tid_ & 63;
    unsigned char* ws = a.ws;
    const int gw = C.vcu * 8 + C.wave, NGW = C.G * 8;
    const bf16_t* CT = (const bf16_t*)(ws + WS_CONTRIB); bf16_t* XB = (bf16_t*)(ws + WS_X1); bf16_t* PB = (bf16_t*)(ws + WS_PB); float* RS3 = (float*)(ws + WS_RSTD3);
    u32x4 xn[2], c0n[2], c1n[2]; f32x4 pn = {0.f, 0.f, 0.f, 0.f};
#define P8_LOAD(tt) do { const int t_ = (tt); _Pragma("unroll") for (int j = 0; j < 2; ++j) { xn[j] = ((const u32x4*)(XB + (size_t)t_ * DM) + lane_)[64 * j]; \
        c0n[j] = ((const u32x4*)(CT + (size_t)(2 * t_) * DM) + lane_)[64 * j]; c1n[j] = ((const u32x4*)(CT + (size_t)(2 * t_ + 1) * DM) + lane_)[64 * j]; } \
        pn = *((const f32x4*)(a.in[1] + (size_t)t_ * PLE) + lane_); } while (0)
    if (gw < T) P8_LOAD(gw);
    for (int t = gw; t < T; t += NGW) {
        u32x4 xv[2], u0[2], u1[2]; const f32x4 pv = pn;
#pragma unroll
        for (int j = 0; j < 2; ++j) { xv[j] = xn[j]; u0[j] = c0n[j]; u1[j] = c1n[j]; }
        if (t + NGW < T) P8_LOAD(t + NGW);
        float ss = 0.f;
#pragma unroll
        for (int j = 0; j < 2; ++j) { u32x4 o;
#pragma unroll
            for (int q = 0; q < 4; ++q) { const float lo = (bflo(xv[j][q]) + bflo(u0[j][q])) + bflo(u1[j][q]), hi = (bfhi(xv[j][q]) + bfhi(u0[j][q])) + bfhi(u1[j][q]); ss += lo * lo + hi * hi; o[q] = pk2(lo, hi); }
            ((u32x4*)(XB + (size_t)t * DM) + lane_)[64 * j] = o; }
        ss = wave_sum(ss);
        if (lane_ == 0) RS3[t] = 1.0f / sqrtf(ss * (1.0f / DM) + RMS_EPS);
        *((u32x2*)(PB + (size_t)t * PLE) + lane_) = (u32x2){pk2(pv.x, pv.y), pk2(pv.z, pv.w)};
    }
#undef P8_LOAD
}


struct P3Sched {
    const char* Y; const char* WFp; const char* WMp; int vcu, G;
    __device__ __forceinline__ bool next(int i, pg8::GUnit& u) const {
        if (i >= 8) return false; const int Lt = (i >> 1) * G + vcu; if (Lt >= 512) return false;
        const int pm = Lt >> 2, pn = Lt & 3, pass = i & 1; u.x0 = pm; u.x1 = pn; u.x2 = pass; u.x3 = 0;
        u.a0 = Y + (size_t)pass * T * AW * 2 + (size_t)pm * 256 * 1024; u.a1 = u.a0 + (size_t)128 * 1024;
        u.b0 = (pass ? WMp : WFp) + (size_t)pn * 256 * 1024; u.b1 = u.b0 + (size_t)128 * 1024; return true; }
};
struct P3Epi {
    const bf16_t* SA; const bf16_t* SB; bf16_t* MX;
    __device__ __forceinline__ void operator()(Acc& acc, const pg8::GUnit& u, int wr, int wc, int fr, int fq) const {
        const int cb = u.x1 * 256 + 32 * wc + 8 * fq; const bf16_t* G = u.x2 ? SB : SA;
#pragma unroll
        for (int ai = 0; ai < 2; ++ai) {
            u32x4 gv[4][2], pv[4][2];
#pragma unroll
            for (int m = 0; m < 4; ++m) { const size_t ro = (size_t)(u.x0 * 256 + 128 * ai + 64 * wr + RL(m, fr)) * DM + cb;
#pragma unroll
                for (int bj = 0; bj < 2; ++bj) { gv[m][bj] = *(const u32x4*)(G + ro + 128 * bj); if (u.x2) pv[m][bj] = *(const u32x4*)(MX + ro + 128 * bj); } }
#pragma unroll
            for (int m = 0; m < 4; ++m) { const size_t ro = (size_t)(u.x0 * 256 + 128 * ai + 64 * wr + RL(m, fr)) * DM + cb;
#pragma unroll
                for (int bj = 0; bj < 2; ++bj) { const u32x4 g = gv[m][bj]; const f32x4 y = acc[ai][bj][m][0], z = acc[ai][bj][m][1];
                    float r0 = sigmoidf_(bflo(g.x)) * y.x, r1 = sigmoidf_(bfhi(g.x)) * y.y, r2 = sigmoidf_(bflo(g.y)) * y.z, r3 = sigmoidf_(bfhi(g.y)) * y.w,
                          r4 = sigmoidf_(bflo(g.z)) * z.x, r5 = sigmoidf_(bfhi(g.z)) * z.y, r6 = sigmoidf_(bflo(g.w)) * z.z, r7 = sigmoidf_(bfhi(g.w)) * z.w;
                    if (u.x2) { const u32x4 p = pv[m][bj]; r0 += bflo(p.x); r1 += bfhi(p.x); r2 += bflo(p.y); r3 += bfhi(p.y); r4 += bflo(p.z); r5 += bfhi(p.z); r6 += bflo(p.w); r7 += bfhi(p.w); }
                    *(u32x4*)(MX + ro + 128 * bj) = (u32x4){pk2(r0, r1), pk2(r2, r3), pk2(r4, r5), pk2(r6, r7)}; } }
            EPI_FENCE(); }
    }
};
struct P34Sched {
    const char* Y; const char* WFp; const char* WMp; const char* MXp; const char* WOp; unsigned* ctl; int vcu, G, n3, n4;
    __device__ __forceinline__ bool next(int i, pg8::SUnit& u) const {
        if (i < 2 * n3) { const int Lt = (i >> 1) * G + vcu, pm = Lt >> 2, pn = Lt & 3, pass = i & 1; u.x0 = pm; u.x1 = pn; u.x2 = pass; u.x3 = 0;
            u.a0 = Y + (size_t)pass * T * AW * 2 + (size_t)pm * 256 * 1024; u.a1 = u.a0 + (size_t)128 * 1024;
            u.b0 = (pass ? WMp : WFp) + (size_t)pn * 256 * 1024; u.b1 = u.b0 + (size_t)128 * 1024; u.flags = pass ? pg8::SF_PUBLISH : 0; return true; }
        if (i < 2 * n3 + 2 * n4) { const int j = i - 2 * n3, L = (j >> 1) * G + vcu, pm = L >> 2, pn = L & 3, half = j & 1; u.x0 = pm; u.x1 = pn; u.x2 = 0; u.x3 = 1;
            u.a0 = MXp + (size_t)pm * 256 * 2048 + half * 1024; u.a1 = u.a0 + (size_t)128 * 2048; u.b0 = WOp + (size_t)pn * 256 * 2048 + half * 1024; u.b1 = u.b0 + (size_t)128 * 2048;
            u.flags = pg8::SF_PITCH1 | (half == 0 ? (pg8::SF_CHAIN | pg8::SF_WAIT) : pg8::SF_PUBLISH); return true; }
        return false; }
    __device__ __forceinline__ void avoff(const pg8::SUnit&, const int (&)[2], const int (&)[2], unsigned (&)[2], unsigned (&)[2]) const {}
    __device__ __forceinline__ void a_ready(const pg8::SUnit& u, int wid) const {
        if (u.flags & pg8::SF_WAIT) {
            if (wid == 0) { unsigned* cnt = ctl + CW_P34 + 64 * u.x0; unsigned sp = 0u;
                while ((unsigned)__builtin_amdgcn_readfirstlane(__hip_atomic_load(cnt, __ATOMIC_RELAXED, __HIP_MEMORY_SCOPE_AGENT)) < 32u) {
                    __builtin_amdgcn_s_sleep(2);
                    if (++sp > (1u << 22)) { if (lane_id_() == 0) __hip_atomic_store(ctl + CW_XTMO, 3u, __ATOMIC_RELAXED, __HIP_MEMORY_SCOPE_AGENT); break; } }
                __builtin_amdgcn_fence(__ATOMIC_ACQUIRE, "agent");
                asm volatile("s_waitcnt vmcnt(0)" ::: "memory"); }
            asm volatile("" ::: "memory"); __builtin_amdgcn_s_barrier(); asm volatile("" ::: "memory");
        } }
    __device__ __forceinline__ void done(const pg8::SUnit& u, int lane) const {
        if (u.flags & pg8::SF_PUBLISH) { asm volatile("s_waitcnt vmcnt(0)" ::: "memory");
            if (lane == 0) __hip_atomic_fetch_add(ctl + (u.x3 ? CW_P45 : CW_P34) + 64 * u.x0, 1u, __ATOMIC_RELAXED, __HIP_MEMORY_SCOPE_AGENT); } }
};
struct P34Epi {
    static constexpr int NST = 0;
    const bf16_t* SA; const bf16_t* SB; bf16_t* MX; const float* x; bf16_t* xb;
    __device__ __forceinline__ void operator()(Acc& acc, const pg8::SUnit& u, int wr, int wc, int fr, int fq) const {
        const int cb = u.x1 * 256 + 32 * wc + 8 * fq;
        if (u.x3 == 0) {
            const bf16_t* G = u.x2 ? SB : SA;
#pragma unroll
            for (int ai = 0; ai < 2; ++ai) {
                u32x4 gv[4][2], pv[4][2];
#pragma unroll
                for (int m = 0; m < 4; ++m) { const size_t ro = (size_t)(u.x0 * 256 + 128 * ai + 64 * wr + RL(m, fr)) * DM + cb;
#pragma unroll
                    for (int bj = 0; bj < 2; ++bj) { gv[m][bj] = *(const u32x4*)(G + ro + 128 * bj); if (u.x2) pv[m][bj] = *(const u32x4*)(MX + ro + 128 * bj); } }
#pragma unroll
                for (int m = 0; m < 4; ++m) { const size_t ro = (size_t)(u.x0 * 256 + 128 * ai + 64 * wr + RL(m, fr)) * DM + cb;
#pragma unroll
                    for (int bj = 0; bj < 2; ++bj) { const u32x4 g = gv[m][bj]; const f32x4 y = acc[ai][bj][m][0], z = acc[ai][bj][m][1];
                        float r0 = sigmoid2_(bflo(g.x)) * y.x, r1 = sigmoid2_(bfhi(g.x)) * y.y, r2 = sigmoid2_(bflo(g.y)) * y.z, r3 = sigmoid2_(bfhi(g.y)) * y.w,
                              r4 = sigmoid2_(bflo(g.z)) * z.x, r5 = sigmoid2_(bfhi(g.z)) * z.y, r6 = sigmoid2_(bflo(g.w)) * z.z, r7 = sigmoid2_(bfhi(g.w)) * z.w;
                        if (u.x2) { const u32x4 p = pv[m][bj]; r0 += bflo(p.x); r1 += bfhi(p.x); r2 += bflo(p.y); r3 += bfhi(p.y); r4 += bflo(p.z); r5 += bfhi(p.z); r6 += bflo(p.w); r7 += bfhi(p.w); }
                        const u32x4 ov = {pk2(r0, r1), pk2(r2, r3), pk2(r4, r5), pk2(r6, r7)}; bf16_t* rp = MX + ro + 128 * bj;
                        if (u.x2) asm volatile("global_store_dwordx4 %0, %1, off sc1\n\ts_nop 1" :: "v"(rp), "v"(ov) : "memory");
                        else *(u32x4*)rp = ov; } }
                EPI_FENCE(); }
        } else {
#pragma unroll
            for (int ai = 0; ai < 2; ++ai)
#pragma unroll
                for (int mh = 0; mh < 2; ++mh) {
                    f32x4 xv[2][2][2];
#pragma unroll
                    for (int m2 = 0; m2 < 2; ++m2) { const size_t ro = (size_t)(u.x0 * 256 + 128 * ai + 64 * wr + RL(2 * mh + m2, fr)) * DM + cb;
#pragma unroll
                        for (int bj = 0; bj < 2; ++bj)
#pragma unroll
                            for (int n = 0; n < 2; ++n) xv[m2][bj][n] = *(const f32x4*)(x + ro + 128 * bj + 4 * n); }
#pragma unroll
                    for (int m2 = 0; m2 < 2; ++m2) { const int m = 2 * mh + m2; const size_t ro = (size_t)(u.x0 * 256 + 128 * ai + 64 * wr + RL(m, fr)) * DM + cb;
#pragma unroll
                        for (int bj = 0; bj < 2; ++bj) { const f32x4 v = xv[m2][bj][0] + acc[ai][bj][m][0], w = xv[m2][bj][1] + acc[ai][bj][m][1];
                            const u32x4 ov = {pk2(v.x, v.y), pk2(v.z, v.w), pk2(w.x, w.y), pk2(w.z, w.w)}; bf16_t* rp = xb + ro + 128 * bj;
                            asm volatile("global_store_dwordx4 %0, %1, off sc1\n\ts_nop 1" :: "v"(rp), "v"(ov) : "memory"); } }
                    EPI_FENCE(); }
        }
    }
};
struct P9Sched {
    const char* A; const char* B; int rowbytes, vcu, G;
    __device__ __forceinline__ bool next(int i, pg8::GUnit& u) const {
        const int Lt = i * G + vcu; if (Lt >= 512) return false;
        const int pm = Lt >> 2, pn = Lt & 3; u.x0 = pm; u.x1 = pn; u.x2 = 0; u.x3 = 0;
        u.a0 = A + (size_t)pm * 256 * rowbytes; u.a1 = u.a0 + (size_t)128 * rowbytes; u.b0 = B + (size_t)pn * 256 * rowbytes; u.b1 = u.b0 + (size_t)128 * rowbytes; return true; }
};
struct P9EpiA {
    bf16_t* PPB;
    __device__ __forceinline__ void operator()(Acc& acc, const pg8::GUnit& u, int wr, int wc, int fr, int fq) const {
        const int cb = u.x1 * 256 + 32 * wc + 8 * fq;
#pragma unroll
        for (int ai = 0; ai < 2; ++ai)
#pragma unroll
            for (int m = 0; m < 4; ++m) { bf16_t* rp = PPB + (size_t)(u.x0 * 256 + 128 * ai + 64 * wr + RL(m, fr)) * DM + cb;
#pragma unroll
                for (int bj = 0; bj < 2; ++bj)
#pragma unroll
                    for (int n = 0; n < 2; ++n) { const f32x4 v = acc[ai][bj][m][n]; *(u32x2*)(rp + 128 * bj + 4 * n) = (u32x2){pk2(v.x, v.y), pk2(v.z, v.w)}; }
                EPI_FENCE(); }
    }
};
struct P9EpiB {
    const bf16_t* PPB; const bf16_t* XB; const float* RS3; float* out; const float* gfin; float* xslot; unsigned* ctl; LAS unsigned char* tail;
    __device__ __forceinline__ void operator()(Acc& acc, const pg8::GUnit& u, int wr, int wc, int fr, int fq) const {
        const int tid = 256 * wr + 64 * wc + 16 * fq + fr, wid = 4 * wr + wc;
        const int cb = u.x1 * 256 + 32 * wc + 8 * fq;
        LAS float* P = (LAS float*)tail; LAS float* S = (LAS float*)(tail + 4096);
#pragma unroll
        for (int ai = 0; ai < 2; ++ai)
#pragma unroll
            for (int mh = 0; mh < 2; ++mh) {
                float rsv[2]; u32x4 ppv[2][2], xvv[2][2];
#pragma unroll
                for (int m2 = 0; m2 < 2; ++m2) { const int row = u.x0 * 256 + 128 * ai + 64 * wr + RL(2 * mh + m2, fr); rsv[m2] = RS3[row]; const size_t ro = (size_t)row * DM + cb;
#pragma unroll
                    for (int bj = 0; bj < 2; ++bj) { ppv[m2][bj] = *(const u32x4*)(PPB + ro + 128 * bj); xvv[m2][bj] = *(const u32x4*)(XB + ro + 128 * bj); } }
#pragma unroll
                for (int m2 = 0; m2 < 2; ++m2) { const int m = 2 * mh + m2; const float rs = rsv[m2]; float s = 0.f;
#pragma unroll
                    for (int bj = 0; bj < 2; ++bj)
#pragma unroll
                        for (int n = 0; n < 2; ++n) { const f32x4 g = acc[ai][bj][m][n] * (rs * -1.4426950408889634f); const unsigned pl = n ? ppv[m2][bj].z : ppv[m2][bj].x, ph = n ? ppv[m2][bj].w : ppv[m2][bj].y, xl = n ? xvv[m2][bj].z : xvv[m2][bj].x, xh = n ? xvv[m2][bj].w : xvv[m2][bj].y;
                            f32x4 v = {bflo(xl), bfhi(xl), bflo(xh), bfhi(xh)};
                            v.x += sigmoid2_(g.x) * bflo(pl); v.y += sigmoid2_(g.y) * bfhi(pl); v.z += sigmoid2_(g.z) * bflo(ph); v.w += sigmoid2_(g.w) * bfhi(ph);
                            acc[ai][bj][m][n] = v; s += (v.x * v.x + v.y * v.y) + (v.z * v.z + v.w * v.w); }
                    s += __shfl_xor(s, 16); s += __shfl_xor(s, 32);
                    if (fq == 0) P[(128 * ai + 64 * wr + RL(m, fr)) * 4 + wc] = s; }
                EPI_FENCE(); }
        asm volatile("s_waitcnt lgkmcnt(0)" ::: "memory"); __builtin_amdgcn_s_barrier(); asm volatile("" ::: "memory");
        unsigned* cnt = ctl + CW_XCNT + 64 * u.x0;
        if (tid < 256) { const f32x4 q = *(LAS const f32x4*)(P + tid * 4); const float tot = (q.x + q.y) + (q.z + q.w);
            __hip_atomic_store((unsigned*)xslot + (size_t)(u.x0 * 256 + tid) * 4 + u.x1, __float_as_uint(tot), __ATOMIC_RELAXED, __HIP_MEMORY_SCOPE_AGENT); }
        asm volatile("s_waitcnt vmcnt(0)" ::: "memory");
        if (wid < 4 && (tid & 63) == 0) __hip_atomic_fetch_add(cnt, 1u, __ATOMIC_RELAXED, __HIP_MEMORY_SCOPE_AGENT);
        if (wid == 0) {
            unsigned sp = 0u;
            while ((unsigned)__builtin_amdgcn_readfirstlane(__hip_atomic_load(cnt, __ATOMIC_RELAXED, __HIP_MEMORY_SCOPE_AGENT)) < 16u) {
                __builtin_amdgcn_s_sleep(2);
                if (++sp > (1u << 22)) { if ((tid & 63) == 0) __hip_atomic_store(ctl + CW_XTMO, 1u, __ATOMIC_RELAXED, __HIP_MEMORY_SCOPE_AGENT); break; } }
            __builtin_amdgcn_fence(__ATOMIC_ACQUIRE, "agent");
        }
        asm volatile("s_waitcnt vmcnt(0) lgkmcnt(0)" ::: "memory"); __builtin_amdgcn_s_barrier(); asm volatile("" ::: "memory");
        if (tid < 256) { const unsigned* sl = (const unsigned*)xslot + (size_t)(u.x0 * 256 + tid) * 4; float tot = 0.f;
#pragma unroll
            for (int t4 = 0; t4 < 4; ++t4) tot += __uint_as_float(__hip_atomic_load(sl + t4, __ATOMIC_RELAXED, __HIP_MEMORY_SCOPE_AGENT));
            S[tid] = 1.0f / sqrtf(tot * (1.0f / DM) + RMS_EPS); }
        asm volatile("s_waitcnt vmcnt(0) lgkmcnt(0)" ::: "memory"); __builtin_amdgcn_s_barrier(); asm volatile("" ::: "memory");
        f32x4 gv[2][2];
#pragma unroll
        for (int bj = 0; bj < 2; ++bj)
#pragma unroll
            for (int n = 0; n < 2; ++n) gv[bj][n] = *(const f32x4*)(gfin + cb + 128 * bj + 4 * n);
#pragma unroll
        for (int ai = 0; ai < 2; ++ai)
#pragma unroll
            for (int m = 0; m < 4; ++m) { const int rl = 128 * ai + 64 * wr + RL(m, fr); const float rstd = S[rl]; float* rp = out + (size_t)(u.x0 * 256 + rl) * DM + cb;
#pragma unroll
                for (int bj = 0; bj < 2; ++bj)
#pragma unroll
                    for (int n = 0; n < 2; ++n) *(f32x4*)(rp + 128 * bj + 4 * n) = acc[ai][bj][m][n] * rstd * gv[bj][n];
                EPI_FENCE(); }
        asm volatile("s_waitcnt lgkmcnt(0)" ::: "memory"); __builtin_amdgcn_s_barrier(); asm volatile("" ::: "memory");
    }
};

__global__ void __launch_bounds__(512, 2) fwd_kernel(Args args) {
    extern __shared__ __attribute__((aligned(16))) unsigned char lds_raw[];
    Ctx C;
    C.lds = (LAS unsigned char*)lds_raw;
    C.wave = __builtin_amdgcn_readfirstlane((int)threadIdx.x >> 6);
    C.G = gridDim.x; { const int bx = blockIdx.x; C.vcu = (C.G % 8 == 0) ? (bx % 8) * (C.G / 8) + bx / 8 : bx; }
    volatile LAS unsigned* MISC = (volatile LAS unsigned*)(C.lds + MISC_OFF);
    LAS int* TST = (LAS int*)(C.lds + MISC_OFF + 256);
    for (int u = opaque_tid(C); u < (LDS_BYTES - MISC_OFF) / 4; u += 512) ((LAS unsigned*)(C.lds + MISC_OFF))[u] = 0u;
    __syncthreads();
    unsigned* ctl = (unsigned*)(args.ws + WS_CTL);
    XcdBarrier bar; bar.bar = ctl + CW_BAR; bar.x = 0; bar.st = nullptr; bar.wave = C.wave;
    const int lo = args.ph_lo, hi = args.ph_hi;
    if (hi - lo > 1) bar = xcd_barrier_post(ctl + CW_BAR, MISC + 8, C.wave);
#define IN(k) (lo <= (k) && (k) < hi)
#define SEAM(k) do { if (IN(k) && IN((k) + 1)) xcd_barrier(bar); } while (0)

    if (IN(0)) { phase0(C, args); } SEAM(0);
    if (IN(1)) {
        p1_cumsum(C, args);
        { P1Sched S{(const char*)(args.ws + WS_HB), (const char*)(args.ws + WS_W1), (const char*)(args.ws + WS_WV), C.vcu, C.G}; P1Epi E{args.ws};
          pg8::gemm_phase<false>(C.lds, C.wave, 1024, S, E); }
    } SEAM(1);
    if (IN(2)) {
        for (int task = C.vcu * 8 + C.wave; task < 64 * 16 * 8; task += 4 * C.G * 8) moba_select4(C, args, task, C.G * 8);
        if ((C.wave == 0 && lane_id_() == 0)) __hip_atomic_fetch_add(ctl + CW_SELDONE, 1u, __ATOMIC_RELAXED, __HIP_MEMORY_SCOPE_AGENT);
        LAS int* PFX = (LAS int*)(C.lds + MISC_OFF + 1024);
        if ((C.wave == 0 && lane_id_() == 0)) PFX[1025] = 0x7fffffff;
        unsigned nxt_u = 0u;
        if ((C.wave == 0 && lane_id_() == 0)) nxt_u = __hip_atomic_fetch_add(ctl + CW_ATTCTR, 1u, __ATOMIC_RELAXED, __HIP_MEMORY_SCOPE_AGENT);
        for (;;) {
            if ((C.wave == 0 && lane_id_() == 0)) MISC[16] = nxt_u;
            __syncthreads();
            const int u = (int)MISC[16];
            __syncthreads();
            if (PFX[1025] == 0x7fffffff && (u % 11 != 10) && (u - u / 11) >= 1024) {
                if ((C.wave == 0 && lane_id_() == 0)) { unsigned sp = 0u;
                    while (__hip_atomic_load(ctl + CW_SELDONE, __ATOMIC_RELAXED, __HIP_MEMORY_SCOPE_AGENT) < (unsigned)C.G) { __builtin_amdgcn_s_sleep(2);
                        if (++sp > (1u << 22)) { __hip_atomic_store(ctl + CW_XTMO, 5u, __ATOMIC_RELAXED, __HIP_MEMORY_SCOPE_AGENT); break; } } }
                __syncthreads();
                const int t_ = opaque_tid(C), ln_ = t_ & 63;
                const unsigned* LC = (const unsigned*)(args.ws + WS_CTL) + CW_LCNT;
                const int n0 = (int)((__hip_atomic_load(LC + 32 * (2 * t_), __ATOMIC_RELAXED, __HIP_MEMORY_SCOPE_AGENT) + GCHUNK - 1) / GCHUNK);
                const int n1 = (int)((__hip_atomic_load(LC + 32 * (2 * t_ + 1), __ATOMIC_RELAXED, __HIP_MEMORY_SCOPE_AGENT) + GCHUNK - 1) / GCHUNK);
                int inc = n0 + n1;
                for (int o = 1; o < 64; o <<= 1) { const int nb = __shfl_up(inc, o); if (ln_ >= o) inc += nb; }
                LAS int* WT = (LAS int*)(C.lds + MISC_OFF + 512);
                if (ln_ == 63) WT[C.wave] = inc;
                __syncthreads();
                int wbase = 0; for (int w_ = 0; w_ < C.wave; ++w_) wbase += WT[w_];
                const int ex = wbase + inc - (n0 + n1);
                PFX[2 * t_] = ex; PFX[2 * t_ + 1] = ex + n0;
                if (t_ == 511) { PFX[1024] = ex + n0 + n1; PFX[1025] = max(11 * N_CONV_CHUNKS, ((2048 + ex + n0 + n1) * 11 + 9) / 10 + 1); }
                __syncthreads();
            }
            if (u >= PFX[1025]) break;
            if ((C.wave == 0 && lane_id_() == 0)) nxt_u = __hip_atomic_fetch_add(ctl + CW_ATTCTR, 1u, __ATOMIC_RELAXED, __HIP_MEMORY_SCOPE_AGENT);
            if (u % 11 != 10) { const int au = u - u / 11; const int NG = (au < 1024) ? 0 : PFX[1024], NA = 2048 + NG;
                if (au < 1024) attn_unit(C, args, 0, au & 63, 15 - (au >> 6));
                else if (au >= 1024 + NG && au < NA) { const int it = au - 1024 - NG, bh = it >> 4, qb = 15 - (it & 15);
                    if (qb > 0) { const unsigned need = (unsigned)(PFX[(bh + 1) * 16] - PFX[bh * 16]);
                        if ((C.wave == 0 && lane_id_() == 0)) { unsigned sp = 0u;
                            while (__hip_atomic_load(ctl + CW_GDONE + 32 * bh, __ATOMIC_RELAXED, __HIP_MEMORY_SCOPE_AGENT) < need) { __builtin_amdgcn_s_sleep(2);
                                if (++sp > (1u << 22)) { __hip_atomic_store(ctl + CW_XTMO, 6u, __ATOMIC_RELAXED, __HIP_MEMORY_SCOPE_AGENT); break; } } }
                        __syncthreads(); }
                    moba_own_item(C, args, bh, qb); }
                else if (au < 1024 + NG) { const int g = au - 1024; int lo_ = 0, hi_ = 1024;
                    while (hi_ - lo_ > 1) { const int mid = (lo_ + hi_) >> 1; if (PFX[mid] <= g) lo_ = mid; else hi_ = mid; }
                    const int len = (int)__hip_atomic_load((const unsigned*)(args.ws + WS_CTL) + CW_LCNT + 32 * lo_, __ATOMIC_RELAXED, __HIP_MEMORY_SCOPE_AGENT);
                    moba_gather_item(C, args, lo_, g - PFX[lo_], __builtin_amdgcn_readfirstlane(len)); } }
            else {
                const int lane_c = opaque_tid(C) & 63; LAS float* scr = (LAS float*)(C.lds + C.wave * 8704);
                { const int itb = P0_EARLY + (u / 11) * CONV_CHUNK + C.wave; const int n = (itb < P0_NIT) ? min(CONV_CHUNK / 8, (P0_NIT - itb + 7) / 8) : 0; p0_weight_run(args, itb, 8, n, scr, lane_c); }
                __syncthreads();
            }
        }
    } SEAM(2);
    if (IN(3)) {
        int n3 = 0, n4 = 0; for (int i = 0; i < 4; ++i) { if (i * C.G + C.vcu < 512) { ++n3; ++n4; } }
        P34Sched S{(const char*)(args.ws + WS_HB), (const char*)(args.ws + WS_WF), (const char*)(args.ws + WS_WM), (const char*)(args.ws + WS_MIXED), (const char*)(args.ws + WS_WO), ctl, C.vcu, C.G, n3, n4};
        P34Epi E{(const bf16_t*)(args.ws + WS_SA), (const bf16_t*)(args.ws + WS_SB), (bf16_t*)(args.ws + WS_MIXED), args.in[0], (bf16_t*)(args.ws + WS_X1)};
        pg8::gemm_stream(C.lds, C.wave, 512, 1024, S, E);
        for (int u0 = C.vcu * 8; u0 < T / 16; u0 += C.G * 8) {
            if (C.wave == 0) { unsigned* cnt = ctl + CW_P45 + 64 * (u0 >> 4); unsigned sp = 0u;
                while ((unsigned)__builtin_amdgcn_readfirstlane(__hip_atomic_load(cnt, __ATOMIC_RELAXED, __HIP_MEMORY_SCOPE_AGENT)) < 32u) {
                    __builtin_amdgcn_s_sleep(2);
                    if (++sp > (1u << 22)) { if (lane_id_() == 0) __hip_atomic_store(ctl + CW_XTMO, 4u, __ATOMIC_RELAXED, __HIP_MEMORY_SCOPE_AGENT); break; } }
                __builtin_amdgcn_fence(__ATOMIC_ACQUIRE, "agent");
                asm volatile("s_waitcnt vmcnt(0)" ::: "memory"); }
            __syncthreads();
            p5_wave<true>(C, args, u0 + C.wave); }
    } SEAM(5);
    if (IN(6)) {
        const int nun = moe_prepare(C, args, TST);
        int n6 = 0, n7; for (int i = 0; i < 8; ++i) if (i * C.G + C.vcu < nun) ++n6;
        (void)moe_down_unit(nun, C.vcu, C.G, 0, n7);
        MoeSched S{(const char*)(args.ws + WS_X1), (const char*)(args.ws + WS_WG), (const char*)(args.ws + WS_WU), (const char*)(args.ws + WS_HBUF), (const char*)(args.ws + WS_WD),
                   (LAS const int*)(C.lds + UD_OFF), (LAS const int*)(C.lds + UL_OFF), ctl, n6, n7};
        MoeEpi E{(const float*)(args.ws + WS_RSTD2), (bf16_t*)(args.ws + WS_HBUF), (const float*)(args.ws + WS_TOKW), (bf16_t*)(args.ws + WS_CONTRIB), (LAS const int*)(C.lds + UL_OFF), (LAS const int*)(C.lds + UD_OFF), (const int*)(args.ws + WS_LISTS)};
        pg8::gemm_stream(C.lds, C.wave, 512, 1024, S, E);
    } SEAM(7);
    if (IN(8)) { phase8(C, args, args.out); } SEAM(8);
    if (IN(9)) {
        { P9Sched S{(const char*)(args.ws + WS_PB), (const char*)(args.ws + WS_WPP), 512, C.vcu, C.G}; P9EpiA E{(bf16_t*)(args.ws + WS_QF)};
          pg8::gemm_phase<false>(C.lds, C.wave, 256, S, E); }
        { P9Sched S{(const char*)(args.ws + WS_X1), (const char*)(args.ws + WS_WPG), 2048, C.vcu, C.G}; P9EpiB E{(const bf16_t*)(args.ws + WS_QF), (const bf16_t*)(args.ws + WS_X1), (const float*)(args.ws + WS_RSTD3), args.out, args.in[19], (float*)(args.ws + WS_XSLOT), ctl, C.lds + MISC_OFF + 4096};
          pg8::gemm_phase<false>(C.lds, C.wave, 1024, S, E); }
    }
#undef IN
#undef SEAM
}

extern "C" void kernel_launch(void* const* d_in, const int* in_sizes, int n_in, void* d_out, int out_size, void* d_ws, size_t ws_size, hipStream_t stream) {
    static int grid = 0;
    if (grid == 0) {
        if (n_in != 20 || in_sizes[0] != T * DM || out_size != T * DM || ws_size < WS_END) { fprintf(stderr, "kernel_launch: unexpected shapes (n_in %d, ws %zu)\n", n_in, ws_size); grid = -1; return; }
        int dev = 0, cus = 0, per_cu = 0;
        if (hipGetDevice(&dev) != hipSuccess || hipDeviceGetAttribute(&cus, hipDeviceAttributeMultiprocessorCount, dev) != hipSuccess) { grid = -1; return; }
        if (hipFuncSetAttribute((const void*)fwd_kernel, hipFuncAttributeMaxDynamicSharedMemorySize, LDS_BYTES) != hipSuccess) { fprintf(stderr, "kernel_launch: hipFuncSetAttribute failed\n"); grid = -1; return; }
        if (hipOccupancyMaxActiveBlocksPerMultiprocessor(&per_cu, (const void*)fwd_kernel, 512, LDS_BYTES) != hipSuccess || per_cu < 1) { fprintf(stderr, "kernel_launch: occupancy query says %d blocks/CU\n", per_cu); (void)hipGetLastError(); grid = -1; return; }
        grid = cus;
    }
    if (grid < 0) return;
    if (hipMemsetAsync((char*)d_ws + WS_CTL, 0, CTL_BYTES, stream) != hipSuccess) return;
    Args a{};
    for (int i = 0; i < 20; ++i) a.in[i] = (const float*)d_in[i];
    a.out = (float*)d_out; a.ws = (unsigned char*)d_ws;
    if (MK_N_LAUNCHES == 1) {
        a.ph_lo = 0; a.ph_hi = NPH;
        hipLaunchKernelGGL(fwd_kernel, dim3(grid), dim3(512), LDS_BYTES, stream, a);
    } else {
        for (int p = 0; p < NPH; ++p) { a.ph_lo = p; a.ph_hi = p + 1; hipLaunchKernelGGL(fwd_kernel, dim3(grid), dim3(512), LDS_BYTES, stream, a); }
    }
}
```
